# Optimizing an MI355X kernel written in HIP

```python
import math
import jax
import jax.numpy as jnp
from jax import lax
import numpy as np

D_MODEL = 1024
BATCH = 8
SEQ = 8192
DEPTH = 1
DEC_BATCH = 16
DEC_SEQ = 32
PAST_LEN = 1024

CHUNK = 64
EPS = 1e-6
D_INNER = 2 * D_MODEL
M_HEAD_DIM = 64
M_HEADS = D_INNER // M_HEAD_DIM
M_GROUPS = 4
M_HPG = M_HEADS // M_GROUPS
D_STATE = 128
CONV_W = 4
CONV_DIM = D_INNER + 2 * M_GROUPS * D_STATE
A_HEADS = 16
A_KV = 4
A_REP = A_HEADS // A_KV
A_HEAD_DIM = 64
A_WIDTH = A_HEADS * A_HEAD_DIM
WINDOW = 128
BAND = WINDOW // CHUNK
ROT_DIM = A_HEAD_DIM // 4
ROPE_THETA = 500000.0
ATTN_ROWS = min(WINDOW, PAST_LEN)
D_FF = 2816
IN_SIZES = (D_INNER, CONV_DIM, M_HEADS, A_WIDTH, A_KV * A_HEAD_DIM, A_KV * A_HEAD_DIM, D_MODEL, D_MODEL)
D_IN_PROJ = sum(IN_SIZES)
IN_SPLITS = tuple(int(s) for s in np.cumsum(IN_SIZES)[:-1])

kernel_name = 'macaron_ssd_swa_sink_gated_hybrid_stream_step'


def _rmsnorm(x, g):
    xf = x.astype(jnp.float32)
    y = xf * lax.rsqrt(jnp.mean(xf * xf, axis=-1, keepdims=True) + EPS)
    return (y * g.astype(jnp.float32)).astype(x.dtype)


def _swiglu(x, w_gu, w_down):
    gate, up = jnp.split(x @ w_gu, 2, axis=-1)
    return (jax.nn.silu(gate) * up) @ w_down


def _rope(x, pos):
    half = ROT_DIM // 2
    inv_freq = ROPE_THETA ** (-jnp.arange(0, ROT_DIM, 2, dtype=jnp.float32) / ROT_DIM)
    ang = pos.astype(jnp.float32)[:, None] * inv_freq[None, :]
    cos = jnp.cos(ang)[:, None, :]
    sin = jnp.sin(ang)[:, None, :]
    xf = x.astype(jnp.float32)
    x1, x2 = xf[..., :half], xf[..., half:ROT_DIM]
    out = jnp.concatenate([x1 * cos - x2 * sin, x2 * cos + x1 * sin, xf[..., ROT_DIM:]], axis=-1)
    return out.astype(x.dtype)


def _causal_conv(xbc, buf, w, b):
    L = xbc.shape[1]
    full = jnp.concatenate([buf.astype(xbc.dtype), xbc], axis=1)
    out = sum((full[:, j:j + L] * w[j] for j in range(CONV_W)), b)
    return jax.nn.silu(out), full[:, -(CONV_W - 1):]


def _ssd_chunk(xh, dt, Bm, Cm, A, h0):
    L = xh.shape[1]
    acs = jnp.cumsum(dt * A, axis=1)
    causal = jnp.tril(jnp.ones((L, L), dtype=bool))[None, :, :, None, None]
    seg = jnp.exp(jnp.where(causal, acs[:, :, None] - acs[:, None, :], -jnp.inf))
    xdt = xh * dt[..., None]
    cb = jnp.einsum('blgn,bsgn->blsg', Cm, Bm)
    y = jnp.einsum('blsgr,bsgrp->blgrp', cb[..., None] * seg, xdt)
    y = y + jnp.einsum('blgn,bgrpn->blgrp', Cm, h0) * jnp.exp(acs)[..., None]
    to_end = jnp.exp(acs[:, -1:] - acs)
    h = h0 * jnp.exp(acs[:, -1])[..., None, None] + jnp.einsum('blgrp,blgn->bgrpn', xdt * to_end[..., None], Bm)
    return y, h


def _mamba(z, xbc, dt_raw, conv_buf, h0, p):
    f32 = jnp.float32
    xbc, conv_out = _causal_conv(xbc, conv_buf, p['conv_w'], p['conv_b'])
    bsz, L = xbc.shape[:2]
    xs, Bm, Cm = jnp.split(xbc, [D_INNER, D_INNER + M_GROUPS * D_STATE], axis=-1)
    xh = xs.reshape(bsz, L, M_GROUPS, M_HPG, M_HEAD_DIM).astype(f32)
    Bm = Bm.reshape(bsz, L, M_GROUPS, D_STATE).astype(f32)
    Cm = Cm.reshape(bsz, L, M_GROUPS, D_STATE).astype(f32)
    dt = jax.nn.softplus(dt_raw.astype(f32) + p['dt_bias'].astype(f32)).reshape(bsz, L, M_GROUPS, M_HPG)
    A = -jnp.exp(p['a_log'].astype(f32)).reshape(M_GROUPS, M_HPG)
    h = h0.astype(f32).reshape(bsz, M_GROUPS, M_HPG, M_HEAD_DIM, D_STATE)
    cl = min(L, CHUNK)
    nc = L // cl

    def to_chunks(t):
        return jnp.moveaxis(t.reshape(bsz, nc, cl, *t.shape[2:]), 1, 0)

    def step(hc, inp):
        yc, hn = _ssd_chunk(*inp, A, hc)
        return hn, yc

    h_last, ys = lax.scan(step, h, (to_chunks(xh), to_chunks(dt), to_chunks(Bm), to_chunks(Cm)))
    y = jnp.moveaxis(ys, 0, 1).reshape(bsz, L, M_GROUPS, M_HPG, M_HEAD_DIM)
    y = y + p['d_skip'].astype(f32).reshape(M_GROUPS, M_HPG)[..., None] * xh
    y = y.reshape(bsz, L, D_INNER).astype(z.dtype)
    y = _rmsnorm(y * jax.nn.silu(z), p['m_norm_g'])
    ssm_out = h_last.reshape(bsz, M_HEADS, M_HEAD_DIM, D_STATE).astype(z.dtype)
    return y, conv_out, ssm_out


def _sink_attention(q, k, v, sink, key_valid):
    s = jnp.einsum('...qkrd,...skd->...krqs', q, k, preferred_element_type=jnp.float32) * (A_HEAD_DIM ** -0.5)
    if key_valid is not None:
        s = jnp.where(key_valid[..., None, None, None, :], s, -jnp.inf)
    sk = sink.astype(jnp.float32).reshape(A_KV, A_REP)[:, :, None, None]
    m = jnp.maximum(jnp.max(s, axis=-1, keepdims=True), sk)
    e = jnp.exp(s - m)
    prob = e / (jnp.sum(e, axis=-1, keepdims=True) + jnp.exp(sk - m))
    return jnp.einsum('...krqs,...skd->...qkrd', prob.astype(v.dtype), v)


def _attn_prompt(q, k, v, sink):
    bsz, L = q.shape[:2]
    nc = L // CHUNK
    qc = q.reshape(bsz, nc, CHUNK, A_KV, A_REP, A_HEAD_DIM)

    def band(t):
        tc = t.reshape(bsz, nc, CHUNK, A_KV, A_HEAD_DIM)
        tp = jnp.pad(tc, ((0, 0), (BAND, 0), (0, 0), (0, 0), (0, 0)))
        return jnp.concatenate([tp[:, j:j + nc] for j in range(BAND + 1)], axis=2)

    key_chunk = jnp.arange(nc)[:, None] - BAND + jnp.arange(BAND + 1)[None, :]
    valid = jnp.repeat(key_chunk >= 0, CHUNK, axis=1)
    o = _sink_attention(qc, band(k), band(v), sink, valid)
    return o.reshape(bsz, L, A_WIDTH)


def _attn_sample(q, k, v, k_cache, v_cache, sink):
    bsz, L = q.shape[:2]
    kk = jnp.concatenate([k_cache.astype(k.dtype), k], axis=1)
    vv = jnp.concatenate([v_cache.astype(v.dtype), v], axis=1)
    o = _sink_attention(q.reshape(bsz, L, A_KV, A_REP, A_HEAD_DIM), kk, vv, sink, None)
    return o.reshape(bsz, L, A_WIDTH)


def _layer(x, pos, state, p):
    x = x + 0.5 * _rmsnorm(_swiglu(_rmsnorm(x, p['ffn1_pre_g']), p['ffn1_w_gu'], p['ffn1_w_down']), p['ffn1_post_g'])
    u = _rmsnorm(x, p['mix_pre_g'])
    bsz, L = u.shape[:2]
    z, xbc, dt_raw, q, k, v, g_m, g_a = jnp.split(u @ p['w_in'], IN_SPLITS, axis=-1)
    q = _rope(q.reshape(bsz, L, A_HEADS, A_HEAD_DIM), pos)
    k = _rope(k.reshape(bsz, L, A_KV, A_HEAD_DIM), pos)
    v = v.reshape(bsz, L, A_KV, A_HEAD_DIM)
    if state is None:
        conv_buf = jnp.zeros((bsz, CONV_W - 1, CONV_DIM), u.dtype)
        h0 = jnp.zeros((bsz, M_HEADS, M_HEAD_DIM, D_STATE), jnp.float32)
        attn = _attn_prompt(q, k, v, p['attn_sink'])
        rows = min(WINDOW, L)
        k_out, v_out = k[:, L - rows:], v[:, L - rows:]
    else:
        conv_buf, h0, k_cache, v_cache = state
        attn = _attn_sample(q, k, v, k_cache, v_cache, p['attn_sink'])
        k_out, v_out = k, v
    y_m, conv_out, ssm_out = _mamba(z, xbc, dt_raw, conv_buf, h0, p)
    mixed = jax.nn.sigmoid(g_m) * (y_m @ p['w_br_m']) + jax.nn.sigmoid(g_a) * (attn @ p['w_br_a'])
    x = x + _rmsnorm(mixed @ p['w_o'], p['mix_post_g'])
    x = x + 0.5 * _rmsnorm(_swiglu(_rmsnorm(x, p['ffn2_pre_g']), p['ffn2_w_gu'], p['ffn2_w_down']), p['ffn2_post_g'])
    return x, (conv_out, ssm_out, k_out, v_out)


def setup_inputs(seed: int = 0) -> dict:
    key = jax.random.key(seed)
    ks = iter(jax.random.split(key, 32))
    f32 = jnp.float32

    def nrm(shape, scale):
        return jax.random.normal(next(ks), shape, f32) * scale

    def gain(shape):
        return 1.0 + nrm(shape, 0.02)

    dt_u = jax.random.uniform(next(ks), (DEPTH, M_HEADS), f32)
    dt0 = jnp.exp(dt_u * (math.log(0.1) - math.log(0.001)) + math.log(0.001))
    dt_bias = dt0 + jnp.log(-jnp.expm1(-dt0))
    a_log = jnp.log(jax.random.uniform(next(ks), (DEPTH, M_HEADS), f32, minval=1.0, maxval=16.0))
    return {
        'x_prompt': nrm((BATCH, SEQ, D_MODEL), 1.0),
        'x_sample': nrm((DEC_BATCH, DEC_SEQ, D_MODEL), 1.0),
        'state_conv': nrm((DEPTH, DEC_BATCH, CONV_W - 1, CONV_DIM), 1.0),
        'state_ssm': nrm((DEPTH, DEC_BATCH, M_HEADS, M_HEAD_DIM, D_STATE), 0.1),
        'cache_k': nrm((DEPTH, DEC_BATCH, ATTN_ROWS, A_KV, A_HEAD_DIM), 1.0),
        'cache_v': nrm((DEPTH, DEC_BATCH, ATTN_ROWS, A_KV, A_HEAD_DIM), 1.0),
        'ffn1_pre_g': gain((DEPTH, D_MODEL)),
        'ffn1_w_gu': nrm((DEPTH, D_MODEL, 2 * D_FF), D_MODEL ** -0.5),
        'ffn1_w_down': nrm((DEPTH, D_FF, D_MODEL), D_FF ** -0.5),
        'ffn1_post_g': gain((DEPTH, D_MODEL)),
        'mix_pre_g': gain((DEPTH, D_MODEL)),
        'w_in': nrm((DEPTH, D_MODEL, D_IN_PROJ), D_MODEL ** -0.5),
        'conv_w': nrm((DEPTH, CONV_W, CONV_DIM), CONV_W ** -0.5),
        'conv_b': nrm((DEPTH, CONV_DIM), 0.02),
        'dt_bias': dt_bias,
        'a_log': a_log,
        'd_skip': gain((DEPTH, M_HEADS)),
        'm_norm_g': gain((DEPTH, D_INNER)),
        'attn_sink': nrm((DEPTH, A_HEADS), 1.0),
        'w_br_m': nrm((DEPTH, D_INNER, D_MODEL), D_INNER ** -0.5),
        'w_br_a': nrm((DEPTH, A_WIDTH, D_MODEL), A_WIDTH ** -0.5),
        'w_o': nrm((DEPTH, D_MODEL, D_MODEL), D_MODEL ** -0.5),
        'mix_post_g': gain((DEPTH, D_MODEL)),
        'ffn2_pre_g': gain((DEPTH, D_MODEL)),
        'ffn2_w_gu': nrm((DEPTH, D_MODEL, 2 * D_FF), D_MODEL ** -0.5),
        'ffn2_w_down': nrm((DEPTH, D_FF, D_MODEL), D_FF ** -0.5),
        'ffn2_post_g': gain((DEPTH, D_MODEL)),
    }


def reference(x_prompt, x_sample, state_conv, state_ssm, cache_k, cache_v,
              ffn1_pre_g, ffn1_w_gu, ffn1_w_down, ffn1_post_g,
              mix_pre_g, w_in, conv_w, conv_b, dt_bias, a_log, d_skip, m_norm_g,
              attn_sink, w_br_m, w_br_a, w_o, mix_post_g,
              ffn2_pre_g, ffn2_w_gu, ffn2_w_down, ffn2_post_g):
    pos_p = jnp.arange(x_prompt.shape[1], dtype=jnp.int32)
    pos_s = PAST_LEN + jnp.arange(x_sample.shape[1], dtype=jnp.int32)
    yp, ys = x_prompt, x_sample
    new_p, new_s = [], []
    for l in range(DEPTH):
        p = {
            'ffn1_pre_g': ffn1_pre_g[l], 'ffn1_w_gu': ffn1_w_gu[l], 'ffn1_w_down': ffn1_w_down[l],
            'ffn1_post_g': ffn1_post_g[l], 'mix_pre_g': mix_pre_g[l], 'w_in': w_in[l],
            'conv_w': conv_w[l], 'conv_b': conv_b[l], 'dt_bias': dt_bias[l], 'a_log': a_log[l],
            'd_skip': d_skip[l], 'm_norm_g': m_norm_g[l], 'attn_sink': attn_sink[l],
            'w_br_m': w_br_m[l], 'w_br_a': w_br_a[l], 'w_o': w_o[l], 'mix_post_g': mix_post_g[l],
            'ffn2_pre_g': ffn2_pre_g[l], 'ffn2_w_gu': ffn2_w_gu[l], 'ffn2_w_down': ffn2_w_down[l],
            'ffn2_post_g': ffn2_post_g[l],
        }
        yp, st_p = _layer(yp, pos_p, None, p)
        ys, st_s = _layer(ys, pos_s, (state_conv[l], state_ssm[l], cache_k[l], cache_v[l]), p)
        new_p.append(st_p)
        new_s.append(st_s)
    conv_p, ssm_p, k_p, v_p = [jnp.stack(t) for t in zip(*new_p)]
    conv_s, ssm_s, k_s, v_s = [jnp.stack(t) for t in zip(*new_s)]
    return (yp, ys, conv_p, ssm_p, k_p, v_p, conv_s, ssm_s, k_s, v_s)
```

```cpp
#include <hip/hip_runtime.h>
#include <hip/hip_cooperative_groups.h>
#include <cstdint>
#include <cstdio>
#include <cmath>
namespace cg = cooperative_groups;

#ifndef DBG_YS
#define DBG_YS 0
#endif
#ifndef NO_SAMPLE_OUT
#define NO_SAMPLE_OUT 0
#endif
#ifndef NOSAMPLE
#define NOSAMPLE 0
#endif
#ifndef SIMPLE_ORDER
#define SIMPLE_ORDER 1
#endif
#ifndef SAFE_GEMM
#define SAFE_GEMM 1
#endif
#ifndef DBG_EXPOSE
#define DBG_EXPOSE 0
#endif
#ifndef MULTI_LAUNCH
#define MULTI_LAUNCH 0
#endif

typedef unsigned short bf16_t;
typedef short bf16x8 __attribute__((ext_vector_type(8)));
typedef float f32x4 __attribute__((ext_vector_type(4)));
typedef unsigned u32x4 __attribute__((ext_vector_type(4)));
typedef unsigned u32x2 __attribute__((ext_vector_type(2)));

constexpr int DM = 1024, NB = 8, SEQ = 8192, SB = 16, SL = 32, PAST = 1024;
constexpr int TP = NB * SEQ;
constexpr int TS = SB * SL;
constexpr int TT = TP + TS;
constexpr int DI = 2048, NH = 32, NG = 4, DS = 128, CD_ = 3072, DFF = 2816;
constexpr int NWIN = 8960;
constexpr int SLAB_SEQ = 2;
constexpr int NSLAB = NB / SLAB_SEQ;
constexpr int SLAB_ROWS = SLAB_SEQ * SEQ;
constexpr int LR = SLAB_ROWS + TS;
constexpr int NCH = SEQ / 64;
constexpr int NST = SLAB_SEQ * NCH + SB;
constexpr float EPS = 1e-6f;
constexpr int PZ = 0, PX = 2048, PQ = 5120, PK = 6144, PV = 6400, PG = 6656, PDT = 8704;

constexpr size_t O_Y = 0, O_YS = 67108864, O_CONVP = 67633152, O_SSMP = 67706880, O_KP = 69804032, O_VP = 70066176,
                 O_CONVS = 70328320, O_SSMS = 70475776, O_KS = 74670080, O_VS = 74801152;

struct Params {
    const float *x_prompt, *x_sample, *state_conv, *state_ssm, *cache_k, *cache_v;
    const float *ffn1_pre_g, *ffn1_w_gu, *ffn1_w_down, *ffn1_post_g, *mix_pre_g, *w_in, *conv_w, *conv_b, *dt_bias, *a_log, *d_skip,
        *m_norm_g, *attn_sink, *w_br_m, *w_br_a, *w_o, *mix_post_g, *ffn2_pre_g, *ffn2_w_gu, *ffn2_w_down, *ffn2_post_g;
    float* out;
    bf16_t *WGU1, *WD1, *WIN, *WBRM, *WBRA, *WO, *WGU2, *WD2, *KS, *VS, *U;
    float2* ROPE;
    float* CDEC;
    bf16_t* H;
    float* D;
    bf16_t *PROJ, *XC, *SH, *Y, *AO, *MIX, *QR, *KR;
    float *SSQ, *MIXP, *MIXA;
};

extern __shared__ __attribute__((aligned(16))) unsigned char smem[];
constexpr int LDS_BYTES = 131072;

__device__ __forceinline__ int bid_priv() { int t = blockIdx.x; asm volatile("" : "+s"(t)); return t; }
__device__ __forceinline__ int nblk_priv() { int t = gridDim.x; asm volatile("" : "+s"(t)); return t; }
__device__ __forceinline__ int tid_priv() { int t = threadIdx.x; asm volatile("" : "+v"(t)); return t; }
typedef __bf16 bf16x2_t __attribute__((ext_vector_type(2)));
typedef float f32x2_t __attribute__((ext_vector_type(2)));
__device__ __forceinline__ unsigned pk_bf16(float lo, float hi) { f32x2_t v = {lo, hi}; bf16x2_t b = __builtin_convertvector(v, bf16x2_t); return __builtin_bit_cast(unsigned, b); }
__device__ __forceinline__ float bf_lo(unsigned u) { return __uint_as_float(u << 16); }
__device__ __forceinline__ float bf_hi(unsigned u) { return __uint_as_float(u & 0xffff0000u); }
__device__ __forceinline__ float bf2f(bf16_t h) { return __uint_as_float(((unsigned)h) << 16); }
__device__ __forceinline__ float shx(float v, int m, int lane) { return __int_as_float(__builtin_amdgcn_ds_bpermute((lane ^ m) << 2, __float_as_int(v))); }
__device__ __forceinline__ float shidx(float v, int src, int lane) { return __int_as_float(__builtin_amdgcn_ds_bpermute(src << 2, __float_as_int(v))); }
__device__ __forceinline__ float wave_sum(float v, int lane) {
#pragma unroll
    for (int o = 1; o < 64; o <<= 1) v += shx(v, o, lane);
    return v;
}
__device__ __forceinline__ float san(float v) { return (v == v && fabsf(v) < 1e30f) ? v : 777.f; }
__device__ __forceinline__ float silu_f(float x) { return x / (1.f + __expf(-x)); }
__device__ __forceinline__ float softplus_f(float t) { const float e = __expf(t); return t > 15.f ? t : (t < -15.f ? e : __logf(1.f + e)); }
__device__ __forceinline__ float sigmoid_f(float x) { return 1.f / (1.f + __expf(-x)); }

__device__ __forceinline__ int src_col(int mode, int n) {
    if (mode == 0) return n;
    if (mode == 1) { int pn = n >> 8, j = n & 255; return j < 128 ? pn * 128 + j : DFF + pn * 128 + (j - 128); }
    if (n < 5120) return n;
    if (n < 8704) return n + 32;
    if (n < 8736) return n - 8704 + 5120;
    return -1;
}
__device__ __forceinline__ void tr_jobs(const Params& p) {
    const int bidp = bid_priv(), nblkp = nblk_priv();
    const int tid = tid_priv();
    float* lds = (float*)smem;
    for (int job = 0; job < 8; ++job) {
        const float* W; int K, N, Nout, mode; bf16_t* Wt; const float* ks = nullptr;
        if (job == 0)      { W = p.ffn1_w_gu;   K = DM;  N = 2 * DFF; Wt = p.WGU1; Nout = 2 * DFF; mode = 1; }
        else if (job == 1) { W = p.ffn1_w_down; K = DFF; N = DM;      Wt = p.WD1;  Nout = DM;      mode = 0; }
        else if (job == 2) { W = p.w_in;        K = DM;  N = 8736;    Wt = p.WIN;  Nout = NWIN;    mode = 2; }
        else if (job == 3) { W = p.w_br_m;      K = DI;  N = DM;      Wt = p.WBRM; Nout = DM;      mode = 0; ks = p.m_norm_g; }
        else if (job == 4) { W = p.w_br_a;      K = DM;  N = DM;      Wt = p.WBRA; Nout = DM;      mode = 0; }
        else if (job == 5) { W = p.w_o;         K = DM;  N = DM;      Wt = p.WO;   Nout = DM;      mode = 0; }
        else if (job == 6) { W = p.ffn2_w_gu;   K = DM;  N = 2 * DFF; Wt = p.WGU2; Nout = 2 * DFF; mode = 1; }
        else               { W = p.ffn2_w_down; K = DFF; N = DM;      Wt = p.WD2;  Nout = DM;      mode = 0; }
        const int nnt = Nout / 64, ntile = (K / 64) * nnt;
        for (int t = bidp; t < ntile; t += nblkp) {
            const int nt = t % nnt, kt = t / nnt;
            const int k0 = kt * 64, n0 = nt * 64;
            const int nn = tid & 63, kk0 = tid >> 6;
            const int sc = src_col(mode, n0 + nn);
#pragma unroll
            for (int r = 0; r < 8; ++r) {
                const int kk = kk0 + 8 * r;
                float v = sc >= 0 ? W[(size_t)(k0 + kk) * N + sc] : 0.f;
                if (ks) v *= ks[k0 + kk];
                lds[kk * 65 + nn] = v;
            }
            __syncthreads();
            const int kp = (tid & 31) * 2, nn0 = tid >> 5;
#pragma unroll
            for (int r = 0; r < 4; ++r) {
                const int n2 = nn0 + 16 * r;
                *(unsigned*)(Wt + (size_t)(n0 + n2) * K + k0 + kp) = pk_bf16(lds[kp * 65 + n2], lds[(kp + 1) * 65 + n2]);
            }
            __syncthreads();
        }
    }
}

__device__ __forceinline__ const float* xin_row(const Params& p, int row) {
    return row < TP ? p.x_prompt + (size_t)row * DM : p.x_sample + (size_t)(row - TP) * DM;
}
__device__ __forceinline__ void norm0_phase(const Params& p) {
    const int bidp = bid_priv(), nblkp = nblk_priv();
    const int tidp = tid_priv();
    const int lane = tidp & 63, wv = tidp >> 6;
    for (int row = bidp * 8 + wv; row < TT; row += nblkp * 8) {
        const f32x4* xr = (const f32x4*)xin_row(p, row) + lane;
        f32x4 v[4]; float ss = 0.f;
#pragma unroll
        for (int j = 0; j < 4; ++j) { v[j] = xr[64 * j]; ss += v[j].x * v[j].x + v[j].y * v[j].y + v[j].z * v[j].z + v[j].w * v[j].w; }
        const float rs = rsqrtf(wave_sum(ss, lane) * (1.f / DM) + EPS);
        u32x2* o = (u32x2*)(p.U + (size_t)row * DM) + lane;
#pragma unroll
        for (int j = 0; j < 4; ++j) {
            const f32x4 g = ((const f32x4*)p.ffn1_pre_g)[lane + 64 * j];
            u32x2 w; w.x = pk_bf16(v[j].x * rs * g.x, v[j].y * rs * g.y); w.y = pk_bf16(v[j].z * rs * g.z, v[j].w * rs * g.w);
            o[64 * j] = w;
        }
    }
}
__device__ __forceinline__ void norm_res_row(const float* drow, const float* xold, float* xnew, const float* gpost, float alpha, const float* gpre, bf16_t* xn, int lane) {
    f32x4 d[4], x[4]; float ss = 0.f;
#pragma unroll
    for (int j = 0; j < 4; ++j) { d[j] = ((const f32x4*)drow)[lane + 64 * j]; x[j] = ((const f32x4*)xold)[lane + 64 * j]; ss += d[j].x * d[j].x + d[j].y * d[j].y + d[j].z * d[j].z + d[j].w * d[j].w; }
    const float rs = rsqrtf(wave_sum(ss, lane) * (1.f / DM) + EPS) * alpha;
    float s2 = 0.f;
#pragma unroll
    for (int j = 0; j < 4; ++j) {
        const f32x4 g = ((const f32x4*)gpost)[lane + 64 * j];
        x[j].x += d[j].x * rs * g.x; x[j].y += d[j].y * rs * g.y; x[j].z += d[j].z * rs * g.z; x[j].w += d[j].w * rs * g.w;
        x[j].x = san(x[j].x); x[j].y = san(x[j].y); x[j].z = san(x[j].z); x[j].w = san(x[j].w);
        ((f32x4*)xnew)[lane + 64 * j] = x[j];
        s2 += x[j].x * x[j].x + x[j].y * x[j].y + x[j].z * x[j].z + x[j].w * x[j].w;
    }
    if (gpre) {
        const float r2 = rsqrtf(wave_sum(s2, lane) * (1.f / DM) + EPS);
#pragma unroll
        for (int j = 0; j < 4; ++j) {
            const f32x4 g = ((const f32x4*)gpre)[lane + 64 * j];
            u32x2 w; w.x = pk_bf16(x[j].x * r2 * g.x, x[j].y * r2 * g.y); w.y = pk_bf16(x[j].z * r2 * g.z, x[j].w * r2 * g.w);
            ((u32x2*)xn)[lane + 64 * j] = w;
        }
    }
}

__device__ __forceinline__ int l2g_row(int s, int lrow) { return lrow < SLAB_ROWS ? s * SLAB_ROWS + lrow : TP + (lrow - SLAB_ROWS); }

constexpr int BM = 256, BK = 64, HALF = 128, HT = HALF * BK;
__device__ __forceinline__ int lds_byte(int r, int c) {
    int st = (r >> 4) * 2 + (c >> 5), rr = r & 15, cc = c & 31, ob = rr * 64 + cc * 2;
    return st * 1024 + (ob ^ (((ob >> 9) & 1) << 5));
}
__device__ __forceinline__ void stage_rc(int b, int& R, int& C) {
    int st = b / 1024, sb = b % 1024, swz = sb ^ (((sb >> 9) & 1) << 5);
    R = (st >> 1) * 16 + swz / 64; C = (st & 1) * 32 + (swz % 64) / 2;
}

#define LAS __attribute__((address_space(3)))
enum { EPI_SWIGLU = 0, EPI_F32 = 1, EPI_BF16 = 2 };
struct GemmDesc {
    const bf16_t* A; int lda; const bf16_t* Bt; int ldb; int K;
    int nM, nN;
    int nmain, abase, aextra;
    int epi; int slab;
    bf16_t* Hout; float* Fout; int ldc; int otile0;
};

__device__ __forceinline__ void epi_swiglu(const Params& p, const GemmDesc& g, const f32x4 (&acc)[2][2][4][2], int pm, int pn, int tid) {
    const int wid = tid >> 6, lane = tid & 63, wr = wid >> 2, wc = wid & 3, fr = lane & 15, fq = lane >> 4;
#pragma unroll
    for (int ai = 0; ai < 2; ++ai)
#pragma unroll
        for (int m = 0; m < 4; ++m) {
            const size_t row = (size_t)pm * BM + ai * HALF + wr * 64 + m * 16 + fr;
#pragma unroll
            for (int n = 0; n < 2; ++n) {
                const f32x4 ga = acc[ai][0][m][n], up = acc[ai][1][m][n];
                u32x2 w; w.x = pk_bf16(silu_f(ga.x) * up.x, silu_f(ga.y) * up.y); w.y = pk_bf16(silu_f(ga.z) * up.z, silu_f(ga.w) * up.w);
                *(u32x2*)(g.Hout + row * DFF + pn * 128 + wc * 32 + n * 16 + fq * 4) = w;
            }
        }
}
__device__ __forceinline__ void epi_f32(const GemmDesc& g, const f32x4 (&acc)[2][2][4][2], int pm, int pn, int tid) {
    const int wid = tid >> 6, lane = tid & 63, wr = wid >> 2, wc = wid & 3, fr = lane & 15, fq = lane >> 4;
#pragma unroll
    for (int ai = 0; ai < 2; ++ai)
#pragma unroll
        for (int m = 0; m < 4; ++m) {
            const size_t row = (size_t)pm * BM + ai * HALF + wr * 64 + m * 16 + fr;
#pragma unroll
            for (int bj = 0; bj < 2; ++bj)
#pragma unroll
                for (int n = 0; n < 2; ++n)
                    *(f32x4*)(g.Fout + row * (g.ldc ? g.ldc : DM) + pn * BM + bj * HALF + wc * 32 + n * 16 + fq * 4) = acc[ai][bj][m][n];
        }
}
__device__ __forceinline__ void st_bf16x4(bf16_t* dst, f32x4 v) { u32x2 w; w.x = pk_bf16(v.x, v.y); w.y = pk_bf16(v.z, v.w); *(u32x2*)dst = w; }

__device__ __forceinline__ void epi_bf16(const GemmDesc& g, const f32x4 (&acc)[2][2][4][2], int pm, int pn, int tid) {
    const int wid = tid >> 6, lane = tid & 63, wr = wid >> 2, wc = wid & 3, fr = lane & 15, fq = lane >> 4;
#pragma unroll
    for (int ai = 0; ai < 2; ++ai)
#pragma unroll
        for (int m = 0; m < 4; ++m) {
            const size_t row = (size_t)pm * BM + ai * HALF + wr * 64 + m * 16 + fr;
#pragma unroll
            for (int bj = 0; bj < 2; ++bj)
#pragma unroll
                for (int n = 0; n < 2; ++n)
                    st_bf16x4(g.Hout + row * NWIN + pn * BM + bj * HALF + wc * 32 + n * 16 + fq * 4, acc[ai][bj][m][n]);
        }
}

__device__ __forceinline__ int tile_order(int i, int nM, int nN, int& pm, int& pn, int bid, int nblk) {
#if SIMPLE_ORDER
    { const int L = i * nblk + bid; if (L >= nM * nN) return 0; pm = L % nM; pn = L / nM; return 1; }
#endif
    const int ngroups = (nM + 7) >> 3, g8 = 8 * nN, ntot = ngroups * g8, chunk = (ntot + 7) >> 3;
    const int x = bid & 7, j = bid >> 3, nj = nblk >> 3;
    const int v = i * nj + j;
    if (v >= chunk) return 0;
    const int T = x * chunk + v;
    if (T >= ntot) return 0;
    int group;
    if (nN == 22) group = T / 176; else if (nN == 4) group = T / 32; else if (nN == 35) group = T / 280; else group = T / g8;
    const int within = T - group * g8;
    pm = group * 8 + (within & 7); pn = within >> 3;
    return pm < nM ? 1 : 2;
}

__device__ __forceinline__ void gemm_phase(const Params& p, const GemmDesc& g) {
    const int bidp = bid_priv(), nblkp = nblk_priv();
    LAS unsigned char* lds = (LAS unsigned char*)smem;
    const int tid = tid_priv(), wid = __builtin_amdgcn_readfirstlane(tid >> 6), lane = tid & 63, wr = wid >> 2, wc = wid & 3, fr = lane & 15, fq = lane >> 4;
    const int K = g.K, nt = K / BK;
    constexpr int HTB = HALF * BK * 2;
    unsigned voff[2];
#pragma unroll
    for (int i = 0; i < 2; ++i) { int R, C; stage_rc(tid * 16 + i * 8192, R, C); voff[i] = (unsigned)(R * K + C) * 2u; }
    const size_t kstep = (size_t)(BK * 2);
    const size_t hstep = (size_t)HALF * K * 2;
    const size_t tstep = 2 * hstep;
    const unsigned ldsw = (unsigned)wid * 1024u;
    const int aoff = lds_byte(wr * 64 + fr, fq * 8), boff = lds_byte(wc * 32 + fr, fq * 8);
#define PG8_SA(b, h) (((b) * 2 + (h)) * HTB)
#define PG8_SB(b, h) ((4 + (b) * 2 + (h)) * HTB)
#define PG8_STAGE(bufoff, gbase) do { _Pragma("unroll") for (int _i = 0; _i < 2; ++_i) \
        __builtin_amdgcn_global_load_lds((const unsigned*)((const char*)(gbase) + voff[_i]), (LAS unsigned*)(lds + (bufoff) + ldsw + _i * 8192), 16, 0, 0); } while (0)
#define PG8_LDA(dst, b, h) do { _Pragma("unroll") for (int m = 0; m < 4; ++m) _Pragma("unroll") for (int k = 0; k < 2; ++k) dst[m][k] = *(const LAS bf16x8*)(lds + PG8_SA(b, h) + aoff + m * 2048 + k * 1024); } while (0)
#define PG8_LDB(dst, b, h) do { _Pragma("unroll") for (int n = 0; n < 2; ++n) _Pragma("unroll") for (int k = 0; k < 2; ++k) dst[n][k] = *(const LAS bf16x8*)(lds + PG8_SB(b, h) + boff + n * 2048 + k * 1024); } while (0)
#define PG8_MMA(ai, bj, At, Bt) do { __builtin_amdgcn_s_setprio(1); _Pragma("unroll") for (int m = 0; m < 4; ++m) _Pragma("unroll") for (int n = 0; n < 2; ++n) _Pragma("unroll") for (int k = 0; k < 2; ++k) \
        acc[ai][bj][m][n] = __builtin_amdgcn_mfma_f32_16x16x32_bf16(Bt[n][k], At[m][k], acc[ai][bj][m][n], 0, 0, 0); __builtin_amdgcn_s_setprio(0); } while (0)
#define PG8_WAIT_V(n) asm volatile("s_waitcnt vmcnt(" #n ")" ::: "memory")
#define PG8_WAIT_L(n) asm volatile("s_waitcnt lgkmcnt(" #n ")" ::: "memory")
#define PG8_BAR __builtin_amdgcn_s_barrier()
#define PG8_SCHED __builtin_amdgcn_sched_barrier(0)
    int pm, pn;
    f32x4 acc[2][2][4][2];
    bf16x8 At[4][2], B0[2][2], B1[2][2];
    __syncthreads();
#define STAGE_TILE(b, kt) do { const char* _a = cA + (size_t)(kt) * kstep; const char* _b = cB + (size_t)(kt) * kstep; \
        PG8_STAGE(PG8_SB(b, 0), _b); PG8_STAGE(PG8_SA(b, 0), _a); PG8_STAGE(PG8_SB(b, 1), _b + hstep); PG8_STAGE(PG8_SA(b, 1), _a + hstep); } while (0)
    for (int ui = 0;; ++ui) {
        const int tor = tile_order(ui, g.nM, g.nN, pm, pn, bidp, nblkp);
        if (tor == 0) break;
        if (tor == 2) continue;
#pragma unroll
        for (int a = 0; a < 2; ++a)
#pragma unroll
            for (int b = 0; b < 2; ++b)
#pragma unroll
                for (int m = 0; m < 4; ++m)
#pragma unroll
                    for (int n = 0; n < 2; ++n) acc[a][b][m][n] = (f32x4){0.f, 0.f, 0.f, 0.f};
        const char* cA = (const char*)g.A + (size_t)(g.abase + pm) * tstep;
        const char* cB = (const char*)g.Bt + (size_t)pn * tstep;
        PG8_WAIT_V(0);
        PG8_BAR;
#if SAFE_GEMM
        for (int t = 0; t < nt; ++t) {
            STAGE_TILE(0, t);
            PG8_WAIT_V(0); PG8_BAR;
            PG8_LDB(B0, 0, 0); PG8_LDB(B1, 0, 1); PG8_LDA(At, 0, 0); PG8_WAIT_L(0);
            PG8_MMA(0, 0, At, B0); PG8_MMA(0, 1, At, B1);
            PG8_LDA(At, 0, 1); PG8_WAIT_L(0); PG8_BAR;
            PG8_MMA(1, 0, At, B0); PG8_MMA(1, 1, At, B1);
        }
#else
        STAGE_TILE(0, 0);
        for (int t = 0; t < nt; t += 2) {
            STAGE_TILE(1, t + 1);
            PG8_WAIT_V(8); PG8_BAR;
            PG8_LDB(B0, 0, 0); PG8_LDB(B1, 0, 1); PG8_LDA(At, 0, 0); PG8_WAIT_L(0);
            PG8_MMA(0, 0, At, B0); PG8_MMA(0, 1, At, B1);
            PG8_LDA(At, 0, 1); PG8_WAIT_L(0); PG8_BAR;
            if (t + 2 < nt) STAGE_TILE(0, t + 2);
            PG8_MMA(1, 0, At, B0); PG8_MMA(1, 1, At, B1);
            if (t + 2 < nt) PG8_WAIT_V(8); else PG8_WAIT_V(0);
            PG8_BAR;
            PG8_LDB(B0, 1, 0); PG8_LDB(B1, 1, 1); PG8_LDA(At, 1, 0); PG8_WAIT_L(0);
            PG8_MMA(0, 0, At, B0); PG8_MMA(0, 1, At, B1);
            PG8_LDA(At, 1, 1); PG8_WAIT_L(0); PG8_BAR;
            PG8_MMA(1, 0, At, B0); PG8_MMA(1, 1, At, B1);
        }
#endif
        if (g.epi == EPI_SWIGLU) epi_swiglu(p, g, acc, pm + g.otile0, pn, tid);
        else if (g.epi == EPI_F32) epi_f32(g, acc, pm + g.otile0, pn, tid);
        else if (!(DBG_EXPOSE == 6 && pm >= 64)) epi_bf16(g, acc, pm + g.otile0, pn, tid);
    }
    PG8_WAIT_V(0);
    PG8_BAR;
}

__device__ __forceinline__ void prep_misc(const Params& p) {
    const int bidp = bid_priv(), nblkp = nblk_priv();
    const int tidp = tid_priv();
    const int gt = bidp * 512 + tidp, ng = nblkp * 512;
    for (int i = gt; i < SB * 128 * 64; i += ng) {
        const int c4 = i & 63, r = (i >> 6) & 127, sb = i >> 13;
        const f32x4 k = ((const f32x4*)p.cache_k)[i], v = ((const f32x4*)p.cache_v)[i];
        st_bf16x4(p.KS + ((size_t)sb * 160 + r) * 256 + c4 * 4, k);
        st_bf16x4(p.VS + ((size_t)sb * 160 + r) * 256 + c4 * 4, v);
    }
}

struct RopeTab { float c[8], s[8]; };
__device__ __forceinline__ void rope_make(const Params& p, int pos, RopeTab& t) {
    const double dp = (double)pos * 0.15915494309189535;
#pragma unroll
    for (int i = 0; i < 8; ++i) {
        constexpr double INVF[8] = {1.0, 0.19392274474868576, 0.03760603093086393, 0.007292664737217109, 0.001414213562373095, 0.0002742481756762073, 5.318295896944988e-05, 1.031338537721246e-05};
        const double r = dp * INVF[i];
        const float fr_ = (float)(r - floor(r));
        float u = fr_ - 0.5f;
        float sgn = -1.f;
        if (u > 0.25f) { u = 0.5f - u; } else if (u < -0.25f) { u = -0.5f - u; } else { sgn = 1.f; }
        const float v = 6.283185307179586f * u, v2 = v * v;
        const float sp = v * (1.f + v2 * (-1.6666667e-1f + v2 * (8.3333333e-3f + v2 * (-1.9841270e-4f + v2 * (2.7557319e-6f + v2 * -2.5052108e-8f)))));
        const float cp = 1.f + v2 * (-0.5f + v2 * (4.1666667e-2f + v2 * (-1.3888889e-3f + v2 * (2.4801587e-5f + v2 * (-2.7557319e-7f + v2 * 2.0876757e-9f)))));
        t.s[i] = -sp; t.c[i] = (sgn > 0.f) ? -cp : cp;
    }
}
__device__ __forceinline__ void rope16(float (&x)[16], const RopeTab& t) {
#pragma unroll
    for (int i = 0; i < 8; ++i) {
        const float a0 = x[i], b0 = x[i + 8];
        x[i] = a0 * t.c[i] - b0 * t.s[i]; x[i + 8] = b0 * t.c[i] + a0 * t.s[i];
    }
}
__device__ __forceinline__ void rope_bf16_inplace(bf16_t* ptr, const RopeTab& tab) {
    const u32x4 a = *(const u32x4*)ptr, b = *(const u32x4*)(ptr + 8);
    float x[16];
    x[0] = bf_lo(a.x); x[1] = bf_hi(a.x); x[2] = bf_lo(a.y); x[3] = bf_hi(a.y); x[4] = bf_lo(a.z); x[5] = bf_hi(a.z); x[6] = bf_lo(a.w); x[7] = bf_hi(a.w);
    x[8] = bf_lo(b.x); x[9] = bf_hi(b.x); x[10] = bf_lo(b.y); x[11] = bf_hi(b.y); x[12] = bf_lo(b.z); x[13] = bf_hi(b.z); x[14] = bf_lo(b.w); x[15] = bf_hi(b.w);
    rope16(x, tab);
    u32x4 oa, ob;
    oa.x = pk_bf16(x[0], x[1]); oa.y = pk_bf16(x[2], x[3]); oa.z = pk_bf16(x[4], x[5]); oa.w = pk_bf16(x[6], x[7]);
    ob.x = pk_bf16(x[8], x[9]); ob.y = pk_bf16(x[10], x[11]); ob.z = pk_bf16(x[12], x[13]); ob.w = pk_bf16(x[14], x[15]);
    *(u32x4*)ptr = oa; *(u32x4*)(ptr + 8) = ob;
}
__device__ __forceinline__ void rope_f32_inplace(float* ptr, const RopeTab& tab) {
    float x[16];
#pragma unroll
    for (int q = 0; q < 4; ++q) { const f32x4 v = ((const f32x4*)ptr)[q]; x[4 * q] = v.x; x[4 * q + 1] = v.y; x[4 * q + 2] = v.z; x[4 * q + 3] = v.w; }
    rope16(x, tab);
#pragma unroll
    for (int q = 0; q < 4; ++q) ((f32x4*)ptr)[q] = (f32x4){x[4 * q], x[4 * q + 1], x[4 * q + 2], x[4 * q + 3]};
}
__device__ __forceinline__ void cp64_bf16_f32(const bf16_t* s, bf16_t* dbf, float* df) {
#pragma unroll
    for (int q = 0; q < 8; ++q) {
        const u32x4 a = *(const u32x4*)(s + q * 8);
        if (dbf) *(u32x4*)(dbf + q * 8) = a;
        if (df) { ((f32x4*)df)[2 * q] = (f32x4){bf_lo(a.x), bf_hi(a.x), bf_lo(a.y), bf_hi(a.y)}; ((f32x4*)df)[2 * q + 1] = (f32x4){bf_lo(a.z), bf_hi(a.z), bf_lo(a.w), bf_hi(a.w)}; }
    }
}
__device__ __forceinline__ void rope64(const bf16_t* s, const RopeTab& tab, bf16_t* dbf, float* df) {
    const u32x4 a = *(const u32x4*)s, b = *(const u32x4*)(s + 8);
    float x[16];
    x[0] = bf_lo(a.x); x[1] = bf_hi(a.x); x[2] = bf_lo(a.y); x[3] = bf_hi(a.y); x[4] = bf_lo(a.z); x[5] = bf_hi(a.z); x[6] = bf_lo(a.w); x[7] = bf_hi(a.w);
    x[8] = bf_lo(b.x); x[9] = bf_hi(b.x); x[10] = bf_lo(b.y); x[11] = bf_hi(b.y); x[12] = bf_lo(b.z); x[13] = bf_hi(b.z); x[14] = bf_lo(b.w); x[15] = bf_hi(b.w);
    rope16(x, tab);
    u32x4 oa, ob;
    oa.x = pk_bf16(x[0], x[1]); oa.y = pk_bf16(x[2], x[3]); oa.z = pk_bf16(x[4], x[5]); oa.w = pk_bf16(x[6], x[7]);
    ob.x = pk_bf16(x[8], x[9]); ob.y = pk_bf16(x[10], x[11]); ob.z = pk_bf16(x[12], x[13]); ob.w = pk_bf16(x[14], x[15]);
    *(u32x4*)dbf = oa; *(u32x4*)(dbf + 8) = ob;
    if (df) {
#pragma unroll
        for (int q = 0; q < 4; ++q) ((f32x4*)df)[q] = (f32x4){x[4 * q], x[4 * q + 1], x[4 * q + 2], x[4 * q + 3]};
    }
#pragma unroll
    for (int q = 2; q < 8; ++q) {
        const u32x4 c = *(const u32x4*)(s + q * 8);
        *(u32x4*)(dbf + q * 8) = c;
        if (df) { ((f32x4*)df)[2 * q] = (f32x4){bf_lo(c.x), bf_hi(c.x), bf_lo(c.y), bf_hi(c.y)}; ((f32x4*)df)[2 * q + 1] = (f32x4){bf_lo(c.z), bf_hi(c.z), bf_lo(c.w), bf_hi(c.w)}; }
    }
}
__device__ __forceinline__ void rope_phase(const Params& p, int slab) {
    const int tidp = tid_priv();
    const int bidp = bid_priv(), nblkp = nblk_priv();
    const int gt = bidp * 512 + tidp, ng = nblkp * 512;
    const int nrow = (slab == 0 && !NOSAMPLE) ? LR : SLAB_ROWS;
    for (int idx = gt; idx < nrow * 20; idx += ng) {
        const int lrow = idx / 20, slot = idx - lrow * 20;
        const bool is_sample = lrow >= SLAB_ROWS;
        int sq, l, pos;
        if (!is_sample) { const int grow = slab * SLAB_ROWS + lrow; sq = grow >> 13; l = grow & (SEQ - 1); pos = l; }
        else { const int srow = lrow - SLAB_ROWS; sq = srow >> 5; l = srow & 31; pos = PAST + l; }
        RopeTab tab; rope_make(p, pos, tab);
        const bf16_t* prow = p.PROJ + (size_t)lrow * NWIN;
        if (slot < 16) {
            rope64(prow + PQ + slot * 64, tab, p.QR + (size_t)lrow * DM + slot * 64, nullptr);
        } else {
            const int kh = slot - 16;
            const bf16_t* kp = prow + PK + kh * 64; const bf16_t* vp = prow + PV + kh * 64;
            if (!is_sample) {
                float* kf = nullptr; float* vf = nullptr;
#ifndef NO_KV_OUT
#define NO_KV_OUT 0
#endif
                if (!NO_KV_OUT && l >= SEQ - 128) { const size_t o = ((size_t)sq * 128 + (l - (SEQ - 128))) * 256 + kh * 64; kf = p.out + O_KP + o; vf = p.out + O_VP + o; }
                rope64(kp, tab, p.KR + (size_t)lrow * 256 + kh * 64, kf);
                if (vf) cp64_bf16_f32(vp, nullptr, vf);
            } else {
                const size_t o = ((size_t)sq * SL + l) * 256 + kh * 64, so = ((size_t)sq * 160 + 128 + l) * 256 + kh * 64;
                rope64(kp, tab, p.KS + so, (NO_KV_OUT || NO_SAMPLE_OUT) ? nullptr : p.out + O_KS + o);
                cp64_bf16_f32(vp, p.VS + so, (NO_KV_OUT || NO_SAMPLE_OUT) ? nullptr : p.out + O_VS + o);
            }
        }
    }
}

__device__ __forceinline__ void conv_phase(const Params& p, int slab) {
    const int bidp = bid_priv(), nblkp = nblk_priv();
    const int tidp = tid_priv();
    const int nseg = (slab == 0 && !NOSAMPLE) ? (LR / 32) : (SLAB_ROWS / 32);
    for (int sg = bidp; sg < nseg; sg += nblkp) {
        const int lr0 = sg * 32;
        const bool is_sample = lr0 >= SLAB_ROWS;
        const bool seq_start = is_sample ? true : ((lr0 & (SEQ - 1)) == 0);
        const int sb = is_sample ? (lr0 - SLAB_ROWS) >> 5 : 0;
        for (int u = tidp; u < 384 * 4; u += 512) {
            const int cg8 = u % 384, rb = u / 384;
            const int c = cg8 * 8, r0 = lr0 + rb * 8;
            float w[4][8], bias[8];
#pragma unroll
            for (int j = 0; j < 4; ++j) { const f32x4 a = *(const f32x4*)(p.conv_w + j * CD_ + c), b = *(const f32x4*)(p.conv_w + j * CD_ + c + 4);
                w[j][0] = a.x; w[j][1] = a.y; w[j][2] = a.z; w[j][3] = a.w; w[j][4] = b.x; w[j][5] = b.y; w[j][6] = b.z; w[j][7] = b.w; }
            { const f32x4 a = *(const f32x4*)(p.conv_b + c), b = *(const f32x4*)(p.conv_b + c + 4);
              bias[0] = a.x; bias[1] = a.y; bias[2] = a.z; bias[3] = a.w; bias[4] = b.x; bias[5] = b.y; bias[6] = b.z; bias[7] = b.w; }
            float h0[8], h1[8], h2[8];
            if (rb == 0 && seq_start) {
                if (is_sample) {
                    const float* sc = p.state_conv + (size_t)sb * 3 * CD_ + c;
#pragma unroll
                    for (int e = 0; e < 8; ++e) { h0[e] = sc[e]; h1[e] = sc[CD_ + e]; h2[e] = sc[2 * CD_ + e]; }
                } else {
#pragma unroll
                    for (int e = 0; e < 8; ++e) { h0[e] = 0.f; h1[e] = 0.f; h2[e] = 0.f; }
                }
            } else {
                const u32x4 a0 = *(const u32x4*)(p.PROJ + (size_t)(r0 - 3) * NWIN + PX + c), a1 = *(const u32x4*)(p.PROJ + (size_t)(r0 - 2) * NWIN + PX + c), a2 = *(const u32x4*)(p.PROJ + (size_t)(r0 - 1) * NWIN + PX + c);
                h0[0] = bf_lo(a0.x); h0[1] = bf_hi(a0.x); h0[2] = bf_lo(a0.y); h0[3] = bf_hi(a0.y); h0[4] = bf_lo(a0.z); h0[5] = bf_hi(a0.z); h0[6] = bf_lo(a0.w); h0[7] = bf_hi(a0.w);
                h1[0] = bf_lo(a1.x); h1[1] = bf_hi(a1.x); h1[2] = bf_lo(a1.y); h1[3] = bf_hi(a1.y); h1[4] = bf_lo(a1.z); h1[5] = bf_hi(a1.z); h1[6] = bf_lo(a1.w); h1[7] = bf_hi(a1.w);
                h2[0] = bf_lo(a2.x); h2[1] = bf_hi(a2.x); h2[2] = bf_lo(a2.y); h2[3] = bf_hi(a2.y); h2[4] = bf_lo(a2.z); h2[5] = bf_hi(a2.z); h2[6] = bf_lo(a2.w); h2[7] = bf_hi(a2.w);
            }
#pragma unroll
            for (int rr = 0; rr < 8; ++rr) {
                const u32x4 a = *(const u32x4*)(p.PROJ + (size_t)(r0 + rr) * NWIN + PX + c);
                float x[8]; x[0] = bf_lo(a.x); x[1] = bf_hi(a.x); x[2] = bf_lo(a.y); x[3] = bf_hi(a.y); x[4] = bf_lo(a.z); x[5] = bf_hi(a.z); x[6] = bf_lo(a.w); x[7] = bf_hi(a.w);
                {
                    const int lr = r0 + rr;
                    int so = -1;
                    if (is_sample) { const int l = (lr - SLAB_ROWS) & 31; if (!NO_SAMPLE_OUT && l >= SL - 3) so = (int)O_CONVS + (sb * 3 + (l - (SL - 3))) * CD_ + c; }
                    else { const int grow = slab * SLAB_ROWS + lr, l = grow & (SEQ - 1); if (l >= SEQ - 3) so = (int)O_CONVP + ((grow >> 13) * 3 + (l - (SEQ - 3))) * CD_ + c; }
#ifndef NO_CONV_OUT
#define NO_CONV_OUT 0
#endif
                    if (!NO_CONV_OUT && so >= 0) { *(f32x4*)(p.out + so) = (f32x4){x[0], x[1], x[2], x[3]}; *(f32x4*)(p.out + so + 4) = (f32x4){x[4], x[5], x[6], x[7]}; }
                }
                float o[8];
#pragma unroll
                for (int e = 0; e < 8; ++e) { o[e] = silu_f(bias[e] + w[0][e] * h0[e] + w[1][e] * h1[e] + w[2][e] * h2[e] + w[3][e] * x[e]); h0[e] = h1[e]; h1[e] = h2[e]; h2[e] = x[e]; }
                u32x4 ov; ov.x = pk_bf16(o[0], o[1]); ov.y = pk_bf16(o[2], o[3]); ov.z = pk_bf16(o[4], o[5]); ov.w = pk_bf16(o[6], o[7]);
                *(u32x4*)(p.XC + (size_t)(r0 + rr) * CD_ + c) = ov;
            }
        }
    }
}

constexpr int KL_STRIDE = 72, VT_STRIDE = 200;
__device__ __forceinline__ void attn_phase(const Params& p, int slab) {
    const int bidp = bid_priv(), nblkp = nblk_priv();
    const int tidp = tid_priv();
    bf16_t* Kl = (bf16_t*)smem;
    bf16_t* Vt = (bf16_t*)(smem + 192 * KL_STRIDE * 2);
    const int tid = tidp, wid = tid >> 6, lane = tid & 63, fr = lane & 15, fq = lane >> 4;
    const int nprompt = SLAB_SEQ * NCH * 4;
    const int nitem = nprompt + ((slab == 0 && !NOSAMPLE) ? SB * 4 : 0);
    for (int it = bidp; it < nitem; it += nblkp) {
        int kh, nq, nvalid, qrow0, kvs, vvs; const bf16_t *kb0, *kb1, *kb2, *vb0, *vb1, *vb2;
        if (it < nprompt) {
            kh = it & 3; const int c = (it >> 2) & (NCH - 1), sq = it >> 9;
            nq = 64; nvalid = 64 * (c + 1 < 3 ? c + 1 : 3); qrow0 = sq * SEQ + c * 64; kvs = 256; vvs = NWIN;
            const int c1 = c >= 1 ? c - 1 : 0, c2 = c >= 2 ? c - 2 : 0;
            kb0 = p.KR + (size_t)(sq * SEQ + c * 64) * 256; kb1 = p.KR + (size_t)(sq * SEQ + c1 * 64) * 256; kb2 = p.KR + (size_t)(sq * SEQ + c2 * 64) * 256;
            vb0 = p.PROJ + (size_t)(sq * SEQ + c * 64) * NWIN + PV; vb1 = p.PROJ + (size_t)(sq * SEQ + c1 * 64) * NWIN + PV; vb2 = p.PROJ + (size_t)(sq * SEQ + c2 * 64) * NWIN + PV;
        } else {
            const int j = it - nprompt; kh = j & 3; const int sb = j >> 2;
            nq = 32; nvalid = 160; qrow0 = SLAB_ROWS + sb * SL; kvs = 256; vvs = 256;
            kb0 = p.KS + (size_t)sb * 160 * 256; kb1 = kb0 + 64 * 256; kb2 = kb0 + 128 * 256;
            vb0 = p.VS + (size_t)sb * 160 * 256; vb1 = vb0 + 64 * 256; vb2 = vb0 + 128 * 256;
        }
        __syncthreads();
#pragma unroll
        for (int r = 0; r < 3; ++r) {
            const int idx = tid + 512 * r, slot = idx >> 3, seg = idx & 7;
            u32x4 kv = (u32x4){0u, 0u, 0u, 0u}, vv = (u32x4){0u, 0u, 0u, 0u};
            if (slot < nvalid) {
                const int blk = slot >> 6, rr = slot & 63;
                const bf16_t* kp = (blk == 0 ? kb0 : (blk == 1 ? kb1 : kb2)) + (size_t)rr * kvs + kh * 64 + seg * 8;
                const bf16_t* vp = (blk == 0 ? vb0 : (blk == 1 ? vb1 : vb2)) + (size_t)rr * vvs + kh * 64 + seg * 8;
                kv = *(const u32x4*)kp; vv = *(const u32x4*)vp;
            }
            *(u32x4*)(Kl + slot * KL_STRIDE + seg * 8) = kv;
            bf16_t* vd = Vt + (seg * 8) * VT_STRIDE + slot;
            vd[0 * VT_STRIDE] = (bf16_t)(vv.x & 0xffff); vd[1 * VT_STRIDE] = (bf16_t)(vv.x >> 16);
            vd[2 * VT_STRIDE] = (bf16_t)(vv.y & 0xffff); vd[3 * VT_STRIDE] = (bf16_t)(vv.y >> 16);
            vd[4 * VT_STRIDE] = (bf16_t)(vv.z & 0xffff); vd[5 * VT_STRIDE] = (bf16_t)(vv.z >> 16);
            vd[6 * VT_STRIDE] = (bf16_t)(vv.w & 0xffff); vd[7 * VT_STRIDE] = (bf16_t)(vv.w >> 16);
        }
        __syncthreads();
        const int rep = wid >> 1, th = wid & 1;
        if (th * 32 < nq) {
            const int h = kh * 4 + rep;
            const int ntv = nvalid >> 4;
            bf16x8 qf[2][2];
#pragma unroll
            for (int mt = 0; mt < 2; ++mt)
#pragma unroll
                for (int ks = 0; ks < 2; ++ks)
                    qf[mt][ks] = *(const bf16x8*)(p.QR + (size_t)(qrow0 + th * 32 + mt * 16 + fr) * DM + h * 64 + ks * 32 + fq * 8);
            f32x4 sacc[12][2];
#pragma unroll
            for (int nt = 0; nt < 12; ++nt) {
                sacc[nt][0] = (f32x4){0.f, 0.f, 0.f, 0.f}; sacc[nt][1] = (f32x4){0.f, 0.f, 0.f, 0.f};
                if (nt < ntv) {
#pragma unroll
                    for (int ks = 0; ks < 2; ++ks) {
                        const bf16x8 kf = *(const bf16x8*)(Kl + (nt * 16 + fr) * KL_STRIDE + ks * 32 + fq * 8);
                        sacc[nt][0] = __builtin_amdgcn_mfma_f32_16x16x32_bf16(kf, qf[0][ks], sacc[nt][0], 0, 0, 0);
                        sacc[nt][1] = __builtin_amdgcn_mfma_f32_16x16x32_bf16(kf, qf[1][ks], sacc[nt][1], 0, 0, 0);
                    }
                }
            }
#pragma unroll
            for (int nt = 0; nt < 12; ++nt) { sacc[nt][0] = sacc[nt][0] * 0.125f; sacc[nt][1] = sacc[nt][1] * 0.125f; }
            const float sink = p.attn_sink[h];
            float inv[2];
#pragma unroll
            for (int mt = 0; mt < 2; ++mt) {
                float mx = sink;
#pragma unroll
                for (int nt = 0; nt < 12; ++nt) if (nt < ntv) mx = fmaxf(mx, fmaxf(fmaxf(sacc[nt][mt].x, sacc[nt][mt].y), fmaxf(sacc[nt][mt].z, sacc[nt][mt].w)));
                mx = fmaxf(mx, shx(mx, 16, lane)); mx = fmaxf(mx, shx(mx, 32, lane));
                float sm = 0.f;
#pragma unroll
                for (int nt = 0; nt < 12; ++nt) {
                    if (nt < ntv) {
                        f32x4 e; e.x = __expf(sacc[nt][mt].x - mx); e.y = __expf(sacc[nt][mt].y - mx); e.z = __expf(sacc[nt][mt].z - mx); e.w = __expf(sacc[nt][mt].w - mx);
                        sacc[nt][mt] = e; sm += (e.x + e.y) + (e.z + e.w);
                    }
                }
                sm += shx(sm, 16, lane); sm += shx(sm, 32, lane);
                inv[mt] = 1.f / (sm + __expf(sink - mx));
            }
            f32x4 oacc[4][2];
#pragma unroll
            for (int dt = 0; dt < 4; ++dt) { oacc[dt][0] = (f32x4){0.f, 0.f, 0.f, 0.f}; oacc[dt][1] = (f32x4){0.f, 0.f, 0.f, 0.f}; }
#pragma unroll
            for (int kk = 0; kk < 6; ++kk) {
                if (2 * kk < ntv) {
                    bf16x8 pf[2];
#pragma unroll
                    for (int mt = 0; mt < 2; ++mt) {
                        const f32x4 a = sacc[2 * kk][mt], b = sacc[2 * kk + 1][mt];
                        u32x4 w; w.x = pk_bf16(a.x, a.y); w.y = pk_bf16(a.z, a.w); w.z = pk_bf16(b.x, b.y); w.w = pk_bf16(b.z, b.w);
                        pf[mt] = *(bf16x8*)&w;
                    }
#pragma unroll
                    for (int dt = 0; dt < 4; ++dt) {
                        const bf16_t* vr = Vt + (dt * 16 + fr) * VT_STRIDE + kk * 32 + fq * 4;
                        const u32x2 v0 = *(const u32x2*)vr, v1 = *(const u32x2*)(vr + 16);
                        u32x4 w; w.x = v0.x; w.y = v0.y; w.z = v1.x; w.w = v1.y;
                        const bf16x8 vf = *(bf16x8*)&w;
                        oacc[dt][0] = __builtin_amdgcn_mfma_f32_16x16x32_bf16(vf, pf[0], oacc[dt][0], 0, 0, 0);
                        oacc[dt][1] = __builtin_amdgcn_mfma_f32_16x16x32_bf16(vf, pf[1], oacc[dt][1], 0, 0, 0);
                    }
                }
            }
#pragma unroll
            for (int mt = 0; mt < 2; ++mt)
#pragma unroll
                for (int dt = 0; dt < 4; ++dt) {
                    f32x4 o = oacc[dt][mt] * inv[mt];
                    st_bf16x4(p.AO + (size_t)(qrow0 + th * 32 + mt * 16 + fr) * DM + h * 64 + dt * 16 + fq * 4, o);
                }
        }
    }
}

__device__ __forceinline__ void ssd_item(int it, int slab, int& lr0, int& nvalid, int& slot, int& g) {
    const int nprompt = SLAB_SEQ * NCH * NG;
    if (it < nprompt) { g = it & 3; const int c = (it >> 2) & (NCH - 1), sq = it >> 9; lr0 = sq * SEQ + c * 64; nvalid = 64; slot = sq * NCH + c; }
    else { const int j = it - nprompt; g = j & 3; const int sb = j >> 2; lr0 = SLAB_ROWS + sb * SL; nvalid = 32; slot = SLAB_SEQ * NCH + sb; }
}
constexpr int XT_STRIDE = 72, BT_STRIDE = 72, BC_STRIDE = 136;

__device__ __forceinline__ void ssdA_phase(const Params& p, int slab) {
    const int bidp = bid_priv(), nblkp = nblk_priv();
    const int tidp = tid_priv();
    bf16_t* Xt = (bf16_t*)smem;
    bf16_t* Bt = (bf16_t*)(smem + 512 * XT_STRIDE * 2);
    float* wl = (float*)(smem + 512 * XT_STRIDE * 2 + 128 * BT_STRIDE * 2);
    const int tid = tidp, wid = tid >> 6, lane = tid & 63, fr = lane & 15, fq = lane >> 4;
    const int nitem = SLAB_SEQ * NCH * NG + ((slab == 0 && !NOSAMPLE) ? SB * NG : 0);
    for (int it = bidp; it < nitem; it += nblkp) {
        int lr0, nvalid, slot, g; ssd_item(it, slab, lr0, nvalid, slot, g);
        const int hd = g * 8 + wid;
        __syncthreads();
        {
            const float dtv = lane < nvalid ? softplus_f(bf2f(p.PROJ[(size_t)(lr0 + lane) * NWIN + PDT + hd]) + p.dt_bias[hd]) : 0.f;
            const float Ah = -__expf(p.a_log[hd]);
            float a = dtv * Ah;
#pragma unroll
            for (int o = 1; o < 64; o <<= 1) { const float t = shidx(a, lane >= o ? lane - o : lane, lane); if (lane >= o) a += t; }
            const float tot = shidx(a, 63, lane);
            wl[wid * 64 + lane] = dtv * __expf(tot - a);
            if (lane == 0) p.CDEC[slot * 32 + hd] = __expf(tot);
        }
        __syncthreads();
#pragma unroll
        for (int r = 0; r < 2; ++r) {
            const int idx = tid + 512 * r, l = idx >> 4, seg = idx & 15;
            u32x4 v = (u32x4){0u, 0u, 0u, 0u};
            if (l < nvalid) v = *(const u32x4*)(p.XC + (size_t)(lr0 + l) * CD_ + DI + g * 128 + seg * 8);
            bf16_t* d = Bt + (seg * 8) * BT_STRIDE + l;
            d[0 * BT_STRIDE] = (bf16_t)(v.x & 0xffff); d[1 * BT_STRIDE] = (bf16_t)(v.x >> 16); d[2 * BT_STRIDE] = (bf16_t)(v.y & 0xffff); d[3 * BT_STRIDE] = (bf16_t)(v.y >> 16);
            d[4 * BT_STRIDE] = (bf16_t)(v.z & 0xffff); d[5 * BT_STRIDE] = (bf16_t)(v.z >> 16); d[6 * BT_STRIDE] = (bf16_t)(v.w & 0xffff); d[7 * BT_STRIDE] = (bf16_t)(v.w >> 16);
        }
#pragma unroll
        for (int r = 0; r < 8; ++r) {
            const int idx = tid + 512 * r, l = idx >> 6, seg = idx & 63;
            u32x4 v = (u32x4){0u, 0u, 0u, 0u};
            if (l < nvalid) v = *(const u32x4*)(p.XC + (size_t)(lr0 + l) * CD_ + g * 512 + seg * 8);
            const float sc = wl[(seg >> 3) * 64 + l];
            const unsigned w0 = pk_bf16(bf_lo(v.x) * sc, bf_hi(v.x) * sc), w1 = pk_bf16(bf_lo(v.y) * sc, bf_hi(v.y) * sc), w2 = pk_bf16(bf_lo(v.z) * sc, bf_hi(v.z) * sc), w3 = pk_bf16(bf_lo(v.w) * sc, bf_hi(v.w) * sc);
            bf16_t* d = Xt + (seg * 8) * XT_STRIDE + l;
            d[0 * XT_STRIDE] = (bf16_t)(w0 & 0xffff); d[1 * XT_STRIDE] = (bf16_t)(w0 >> 16); d[2 * XT_STRIDE] = (bf16_t)(w1 & 0xffff); d[3 * XT_STRIDE] = (bf16_t)(w1 >> 16);
            d[4 * XT_STRIDE] = (bf16_t)(w2 & 0xffff); d[5 * XT_STRIDE] = (bf16_t)(w2 >> 16); d[6 * XT_STRIDE] = (bf16_t)(w3 & 0xffff); d[7 * XT_STRIDE] = (bf16_t)(w3 >> 16);
        }
        __syncthreads();
        bf16x8 xf[4][2];
#pragma unroll
        for (int pt = 0; pt < 4; ++pt)
#pragma unroll
            for (int ks = 0; ks < 2; ++ks) xf[pt][ks] = *(const bf16x8*)(Xt + (wid * 64 + pt * 16 + fr) * XT_STRIDE + ks * 32 + fq * 8);
        bf16_t* Sout = p.SH + ((size_t)slot * 32 + hd) * 8192;
#pragma unroll
        for (int half = 0; half < 2; ++half) {
            f32x4 acc[4][4];
#pragma unroll
            for (int nt = 0; nt < 4; ++nt) {
                bf16x8 bfm[2];
#pragma unroll
                for (int ks = 0; ks < 2; ++ks) bfm[ks] = *(const bf16x8*)(Bt + (half * 64 + nt * 16 + fr) * BT_STRIDE + ks * 32 + fq * 8);
#pragma unroll
                for (int pt = 0; pt < 4; ++pt) {
                    f32x4 a = (f32x4){0.f, 0.f, 0.f, 0.f};
                    a = __builtin_amdgcn_mfma_f32_16x16x32_bf16(bfm[0], xf[pt][0], a, 0, 0, 0);
                    a = __builtin_amdgcn_mfma_f32_16x16x32_bf16(bfm[1], xf[pt][1], a, 0, 0, 0);
                    acc[nt][pt] = a;
                }
            }
#pragma unroll
            for (int nt = 0; nt < 4; ++nt)
#pragma unroll
                for (int pt = 0; pt < 4; ++pt)
                    st_bf16x4(Sout + (pt * 16 + fr) * 128 + half * 64 + nt * 16 + fq * 4, acc[nt][pt]);
        }
    }
}

__device__ __forceinline__ void scan_phase(const Params& p, int slab) {
    const int bidp = bid_priv(), nblkp = nblk_priv();
    const int tidp = tid_priv();
    const int gt = bidp * 512 + tidp, ng = nblkp * 512;
    for (int e = gt; e < SLAB_SEQ * 32 * 2048; e += ng) {
        const int n4 = e & 31, pp = (e >> 5) & 63, hd = (e >> 11) & 31, sq = e >> 16;
        const size_t off = (size_t)hd * 8192 + pp * 128 + n4 * 4;
        float h0 = 0.f, h1 = 0.f, h2 = 0.f, h3 = 0.f;
        for (int c0 = 0; c0 < NCH; c0 += 8) {
            u32x2 s[8]; float dc[8];
#pragma unroll
            for (int j = 0; j < 8; ++j) { const int slot = sq * NCH + c0 + j; s[j] = *(const u32x2*)(p.SH + (size_t)slot * 32 * 8192 + off); dc[j] = p.CDEC[slot * 32 + hd]; }
#pragma unroll
            for (int j = 0; j < 8; ++j) {
                const int slot = sq * NCH + c0 + j;
                u32x2 w; w.x = pk_bf16(h0, h1); w.y = pk_bf16(h2, h3);
                *(u32x2*)(p.SH + (size_t)slot * 32 * 8192 + off) = w;
                h0 = h0 * dc[j] + bf_lo(s[j].x); h1 = h1 * dc[j] + bf_hi(s[j].x); h2 = h2 * dc[j] + bf_lo(s[j].y); h3 = h3 * dc[j] + bf_hi(s[j].y);
            }
        }
        const int b = slab * SLAB_SEQ + sq;
        *(f32x4*)(p.out + O_SSMP + (size_t)b * 32 * 8192 + off) = (f32x4){san(h0), san(h1), san(h2), san(h3)};
    }
    if (slab == 0 && !NOSAMPLE) {
        for (int e = gt; e < SB * 32 * 2048; e += ng) {
            const int sb = e >> 16; const size_t off = (size_t)(e & 65535) * 4; const int hd = (e >> 11) & 31;
            const int slot = SLAB_SEQ * NCH + sb;
            const u32x2 s = *(const u32x2*)(p.SH + (size_t)slot * 32 * 8192 + off);
            const float dc = p.CDEC[slot * 32 + hd];
            const f32x4 h = *(const f32x4*)(p.state_ssm + (size_t)sb * 32 * 8192 + off);
            st_bf16x4(p.SH + (size_t)slot * 32 * 8192 + off, h);
            if (!NO_SAMPLE_OUT) *(f32x4*)(p.out + O_SSMS + (size_t)sb * 32 * 8192 + off) = (f32x4){san(h.x * dc + bf_lo(s.x)), san(h.y * dc + bf_hi(s.x)), san(h.z * dc + bf_lo(s.y)), san(h.w * dc + bf_hi(s.y))};
        }
    }
}

__device__ __forceinline__ void ssdC_phase(const Params& p, int slab) {
    const int bidp = bid_priv(), nblkp = nblk_priv();
    const int tidp = tid_priv();
    bf16_t* Xt = (bf16_t*)smem;
    bf16_t* Bl = (bf16_t*)(smem + 512 * XT_STRIDE * 2);
    bf16_t* Cl = Bl + 64 * BC_STRIDE;
    float* acsl = (float*)(Cl + 64 * BC_STRIDE);
    float* dtl = acsl + 512;
    const int tid = tidp, wid = tid >> 6, lane = tid & 63, fr = lane & 15, fq = lane >> 4;
    const int nitem = SLAB_SEQ * NCH * NG + ((slab == 0 && !NOSAMPLE) ? SB * NG : 0);
    for (int it = bidp; it < nitem; it += nblkp) {
        int lr0, nvalid, slot, g; ssd_item(it, slab, lr0, nvalid, slot, g);
        const int hd = g * 8 + wid;
        __syncthreads();
        {
            const float dtv = lane < nvalid ? softplus_f(bf2f(p.PROJ[(size_t)(lr0 + lane) * NWIN + PDT + hd]) + p.dt_bias[hd]) : 0.f;
            const float Ah = -__expf(p.a_log[hd]);
            float a = dtv * Ah;
#pragma unroll
            for (int o = 1; o < 64; o <<= 1) { const float t = shidx(a, lane >= o ? lane - o : lane, lane); if (lane >= o) a += t; }
            acsl[wid * 64 + lane] = a; dtl[wid * 64 + lane] = dtv;
        }
#pragma unroll
        for (int which = 0; which < 2; ++which)
#pragma unroll
            for (int r = 0; r < 2; ++r) {
                const int idx = tid + 512 * r, l = idx >> 4, seg = idx & 15;
                u32x4 v = (u32x4){0u, 0u, 0u, 0u};
                if (l < nvalid) v = *(const u32x4*)(p.XC + (size_t)(lr0 + l) * CD_ + DI + which * 512 + g * 128 + seg * 8);
                *(u32x4*)((which ? Cl : Bl) + l * BC_STRIDE + seg * 8) = v;
            }
#pragma unroll
        for (int r = 0; r < 8; ++r) {
            const int idx = tid + 512 * r, l = idx >> 6, seg = idx & 63;
            u32x4 v = (u32x4){0u, 0u, 0u, 0u};
            if (l < nvalid) v = *(const u32x4*)(p.XC + (size_t)(lr0 + l) * CD_ + g * 512 + seg * 8);
            bf16_t* d = Xt + (seg * 8) * XT_STRIDE + l;
            d[0 * XT_STRIDE] = (bf16_t)(v.x & 0xffff); d[1 * XT_STRIDE] = (bf16_t)(v.x >> 16); d[2 * XT_STRIDE] = (bf16_t)(v.y & 0xffff); d[3 * XT_STRIDE] = (bf16_t)(v.y >> 16);
            d[4 * XT_STRIDE] = (bf16_t)(v.z & 0xffff); d[5 * XT_STRIDE] = (bf16_t)(v.z >> 16); d[6 * XT_STRIDE] = (bf16_t)(v.w & 0xffff); d[7 * XT_STRIDE] = (bf16_t)(v.w >> 16);
        }
        __syncthreads();
        f32x4 cb[4][4];
#pragma unroll
        for (int st = 0; st < 4; ++st)
#pragma unroll
            for (int lt = 0; lt < 4; ++lt) cb[st][lt] = (f32x4){0.f, 0.f, 0.f, 0.f};
#pragma unroll
        for (int ks = 0; ks < 4; ++ks) {
            bf16x8 bfm[4], cfm[4];
#pragma unroll
            for (int t = 0; t < 4; ++t) { bfm[t] = *(const bf16x8*)(Bl + (t * 16 + fr) * BC_STRIDE + ks * 32 + fq * 8); cfm[t] = *(const bf16x8*)(Cl + (t * 16 + fr) * BC_STRIDE + ks * 32 + fq * 8); }
#pragma unroll
            for (int st = 0; st < 4; ++st)
#pragma unroll
                for (int lt = 0; lt < 4; ++lt)
                    if (st <= lt) cb[st][lt] = __builtin_amdgcn_mfma_f32_16x16x32_bf16(bfm[st], cfm[lt], cb[st][lt], 0, 0, 0);
        }
        f32x4 yacc[4][4];
#pragma unroll
        for (int pt = 0; pt < 4; ++pt)
#pragma unroll
            for (int lt = 0; lt < 4; ++lt) yacc[pt][lt] = (f32x4){0.f, 0.f, 0.f, 0.f};
        const bf16_t* Hs = p.SH + ((size_t)slot * 32 + hd) * 8192;
#pragma unroll
        for (int ks = 0; ks < 4; ++ks) {
            bf16x8 hfm[4], cfm[4];
#pragma unroll
            for (int t = 0; t < 4; ++t) { hfm[t] = *(const bf16x8*)(Hs + (t * 16 + fr) * 128 + ks * 32 + fq * 8); cfm[t] = *(const bf16x8*)(Cl + (t * 16 + fr) * BC_STRIDE + ks * 32 + fq * 8); }
#pragma unroll
            for (int pt = 0; pt < 4; ++pt)
#pragma unroll
                for (int lt = 0; lt < 4; ++lt) yacc[pt][lt] = __builtin_amdgcn_mfma_f32_16x16x32_bf16(hfm[pt], cfm[lt], yacc[pt][lt], 0, 0, 0);
        }
        const float* ac = acsl + wid * 64; const float* dl = dtl + wid * 64;
        const float dskip = p.d_skip[hd];
        float acl[4];
#pragma unroll
        for (int lt = 0; lt < 4; ++lt) { acl[lt] = ac[lt * 16 + fr]; const float e = __expf(acl[lt]);
#pragma unroll
            for (int pt = 0; pt < 4; ++pt) yacc[pt][lt] = yacc[pt][lt] * e; }
#pragma unroll
        for (int st = 0; st < 4; ++st) {
            const f32x4 as = *(const f32x4*)(ac + st * 16 + fq * 4), ds = *(const f32x4*)(dl + st * 16 + fq * 4);
#pragma unroll
            for (int lt = 0; lt < 4; ++lt) {
                if (st <= lt) {
                    const int l = lt * 16 + fr, s0 = st * 16 + fq * 4;
                    f32x4 c = cb[st][lt], o;
                    o.x = (s0 + 0 <= l) ? c.x * __expf(acl[lt] - as.x) * ds.x : 0.f;
                    o.y = (s0 + 1 <= l) ? c.y * __expf(acl[lt] - as.y) * ds.y : 0.f;
                    o.z = (s0 + 2 <= l) ? c.z * __expf(acl[lt] - as.z) * ds.z : 0.f;
                    o.w = (s0 + 3 <= l) ? c.w * __expf(acl[lt] - as.w) * ds.w : 0.f;
                    if (s0 + 0 == l) o.x += dskip;
                    if (s0 + 1 == l) o.y += dskip;
                    if (s0 + 2 == l) o.z += dskip;
                    if (s0 + 3 == l) o.w += dskip;
                    cb[st][lt] = o;
                }
            }
        }
#pragma unroll
        for (int kk = 0; kk < 2; ++kk) {
            bf16x8 xf[4];
#pragma unroll
            for (int pt = 0; pt < 4; ++pt) {
                const bf16_t* xr = Xt + (wid * 64 + pt * 16 + fr) * XT_STRIDE + kk * 32 + fq * 4;
                const u32x2 v0 = *(const u32x2*)xr, v1 = *(const u32x2*)(xr + 16);
                u32x4 w; w.x = v0.x; w.y = v0.y; w.z = v1.x; w.w = v1.y; xf[pt] = *(bf16x8*)&w;
            }
#pragma unroll
            for (int lt = 0; lt < 4; ++lt) {
                if (2 * kk <= lt) {
                    const f32x4 a = cb[2 * kk][lt];
                    f32x4 b = (f32x4){0.f, 0.f, 0.f, 0.f};
                    if (2 * kk + 1 <= lt) b = cb[2 * kk + 1][lt];
                    u32x4 w; w.x = pk_bf16(a.x, a.y); w.y = pk_bf16(a.z, a.w); w.z = pk_bf16(b.x, b.y); w.w = pk_bf16(b.z, b.w);
                    const bf16x8 mf = *(bf16x8*)&w;
#pragma unroll
                    for (int pt = 0; pt < 4; ++pt) yacc[pt][lt] = __builtin_amdgcn_mfma_f32_16x16x32_bf16(xf[pt], mf, yacc[pt][lt], 0, 0, 0);
                }
            }
        }
#pragma unroll
        for (int lt = 0; lt < 4; ++lt) {
            const int l = lt * 16 + fr;
            const size_t row = (size_t)(lr0 + l);
            float ss = 0.f;
            const bool ok = l < nvalid;
#pragma unroll
            for (int pt = 0; pt < 4; ++pt) {
                const int col = hd * 64 + pt * 16 + fq * 4;
                u32x2 zw = (u32x2){0u, 0u};
                if (ok) zw = *(const u32x2*)(p.PROJ + row * NWIN + PZ + col);
                f32x4 y = yacc[pt][lt];
                y.x *= silu_f(bf_lo(zw.x)); y.y *= silu_f(bf_hi(zw.x)); y.z *= silu_f(bf_lo(zw.y)); y.w *= silu_f(bf_hi(zw.y));
                ss += (y.x * y.x + y.y * y.y) + (y.z * y.z + y.w * y.w);
                if (ok) st_bf16x4(p.Y + row * DI + col, y);
            }
            ss += shx(ss, 16, lane); ss += shx(ss, 32, lane);
            if (ok && fq == 0) p.SSQ[row * 32 + hd] = ss;
        }
    }
}

__device__ __forceinline__ void mix_phase(const Params& p, int slab) {
    const int tidp = tid_priv();
    const int bidp = bid_priv(), nblkp = nblk_priv();
    const int lane = tidp & 63, wv = tidp >> 6;
    const int nrow = (slab == 0 && !NOSAMPLE) ? LR : SLAB_ROWS;
    for (int lrow = bidp * 8 + wv; lrow < nrow; lrow += nblkp * 8) {
        const float sq = lane < 32 ? p.SSQ[(size_t)lrow * 32 + lane] : 0.f;
        const float rs = rsqrtf(wave_sum(sq, lane) * (1.f / DI) + EPS);
        const bf16_t* gr = p.PROJ + (size_t)lrow * NWIN + PG;
#pragma unroll
        for (int j = 0; j < 4; ++j) {
            const int c = (lane + 64 * j) * 4;
            const f32x4 a = *(const f32x4*)(p.MIXP + (size_t)lrow * DM + c), b = *(const f32x4*)(p.MIXA + (size_t)lrow * DM + c);
            const u32x2 gm = *(const u32x2*)(gr + c), ga = *(const u32x2*)(gr + DM + c);
            f32x4 o;
            o.x = sigmoid_f(bf_lo(gm.x)) * rs * a.x + sigmoid_f(bf_lo(ga.x)) * b.x;
            o.y = sigmoid_f(bf_hi(gm.x)) * rs * a.y + sigmoid_f(bf_hi(ga.x)) * b.y;
            o.z = sigmoid_f(bf_lo(gm.y)) * rs * a.z + sigmoid_f(bf_lo(ga.y)) * b.z;
            o.w = sigmoid_f(bf_hi(gm.y)) * rs * a.w + sigmoid_f(bf_hi(ga.y)) * b.w;
            st_bf16x4(p.MIX + (size_t)lrow * DM + c, o);
        }
    }
}

__device__ __forceinline__ void normres_all(const Params& p, int which) {
    const int bidp = bid_priv(), nblkp = nblk_priv();
    const int tidp = tid_priv();
    const int lane = tidp & 63, wv = tidp >> 6;
    for (int row = bidp * 8 + wv; row < TT; row += nblkp * 8) {
        float* y = p.out + (size_t)row * DM;
        if (which == 0) norm_res_row(p.D + (size_t)row * DM, xin_row(p, row), y, p.ffn1_post_g, 0.5f, p.mix_pre_g, p.U + (size_t)row * DM, lane);
        else norm_res_row(p.D + (size_t)row * DM, y, y, p.ffn2_post_g, 0.5f, nullptr, nullptr, lane);
        if ((NO_SAMPLE_OUT || DBG_YS) && which != 0 && row >= TP) { for (int j = 0; j < 4; ++j) ((u32x4*)y)[lane + 64 * j] = (u32x4){0xAAAAAAAAu, 0xAAAAAAAAu, 0xAAAAAAAAu, 0xAAAAAAAAu}; }
    }
}
__device__ __forceinline__ void normres_slab(const Params& p, int slab) {
    const int bidp = bid_priv(), nblkp = nblk_priv();
    const int tidp = tid_priv();
    const int lane = tidp & 63, wv = tidp >> 6;
    const int nrow = (slab == 0 && !NOSAMPLE) ? LR : SLAB_ROWS;
    for (int lrow = bidp * 8 + wv; lrow < nrow; lrow += nblkp * 8) {
        const int row = l2g_row(slab, lrow);
        float* y = p.out + (size_t)row * DM;
        norm_res_row(p.MIXP + (size_t)lrow * DM, y, y, p.mix_post_g, 1.0f, p.ffn2_pre_g, p.U + (size_t)row * DM, lane);
    }
}

constexpr int PH_PREP = 0, PH_GU1 = 1, PH_DN1 = 2, PH_NR1 = 3, PH_MIX0 = 4, MIX_PHASES = 10, PH_GU2 = PH_MIX0 + NSLAB * MIX_PHASES, PH_DN2 = PH_GU2 + 1, PH_NR3 = PH_GU2 + 2, PH_END = PH_GU2 + 3;

#define NEED_SYNC(ph) (!((ph) >= PH_MIX0 && (ph) < PH_GU2 && ((ph) - PH_MIX0) % MIX_PHASES == 5))
#ifndef PHASE_MASK
#define PHASE_MASK 0xffff
#endif
#define PM(k) ((PHASE_MASK >> (k)) & 1)
__device__ __forceinline__ void run_phase(const Params& p, int ph) {
    GemmDesc g{}; bool is_gemm = false; int nrep = 1;
    if (ph == PH_PREP) {
        if (PM(0)) {
        tr_jobs(p);
        prep_misc(p);
        norm0_phase(p);
        }
    } else if (ph == PH_GU1 || ph == PH_GU2) {
        g.A = p.U; g.lda = DM; g.Bt = ph == PH_GU1 ? p.WGU1 : p.WGU2; g.ldb = DM; g.K = DM; g.nM = TT / BM; g.nN = 2 * DFF / BM; g.nmain = g.nM; g.abase = 0; g.aextra = 0; g.epi = EPI_SWIGLU; g.Hout = p.H;
        is_gemm = true;
    } else if (DBG_EXPOSE == 4 && ph == PH_DN1) {
        const int tidp = tid_priv(); const int gt = bid_priv() * 512 + tidp, ng = nblk_priv() * 512;
        for (int i = gt; i < 16384 * 64; i += ng) {
            const int r = i >> 6, c4 = (i & 63) * 4;
            const u32x2 w = *(const u32x2*)(p.H + (size_t)r * DFF + c4);
            *(f32x4*)(p.out + O_SSMS + (size_t)i * 4) = (f32x4){bf_lo(w.x), bf_hi(w.x), bf_lo(w.y), bf_hi(w.y)};
        }
    } else if (ph == PH_DN1 || ph == PH_DN2) {
        g.A = p.H; g.lda = DFF; g.Bt = ph == PH_DN1 ? p.WD1 : p.WD2; g.ldb = DFF; g.K = DFF; g.nM = TT / BM; g.nN = DM / BM; g.nmain = g.nM; g.abase = 0; g.aextra = 0; g.epi = EPI_F32; g.Fout = p.D;
        is_gemm = true;
    } else if (ph == PH_NR1) {
        if (PM(9)) normres_all(p, 0);
    } else if (ph == PH_NR3) {
        if (PM(9)) normres_all(p, 2);
    } else {
        const int s = (ph - PH_MIX0) / MIX_PHASES, q = (ph - PH_MIX0) % MIX_PHASES;
        const int nlt = SLAB_ROWS / BM + ((s == 0 && !NOSAMPLE) ? TS / BM : 0);
        if (q == 0) {
            g.A = p.U; g.lda = DM; g.Bt = p.WIN; g.ldb = DM; g.K = DM; g.nM = SLAB_ROWS / BM; g.nN = NWIN / BM; g.nmain = g.nM; g.abase = s * (SLAB_ROWS / BM); g.aextra = 0; g.epi = EPI_BF16; g.Hout = p.PROJ; g.slab = s;
            nrep = (s == 0 && !NOSAMPLE) ? 2 : 1;
#if DBG_EXPOSE == 6
            nrep = 1; g.nM = 66; g.nmain = 66;
#endif
            is_gemm = true;
        } else if (q == 1) {
#if DBG_EXPOSE
            {
                const int tidp = tid_priv(); const int gt = bid_priv() * 512 + tidp, ng = nblk_priv() * 512;
                for (int i = gt; i < 16384 * 64; i += ng) {
                    const int r = i >> 6, c4 = (i & 63) * 4;
#if DBG_EXPOSE == 6
                    const u32x2 w = *(const u32x2*)(p.PROJ + (size_t)r * NWIN + PZ + c4);
#elif DBG_EXPOSE == 5
                    const f32x4 wf = *(const f32x4*)((const float*)p.PROJ + (size_t)r * NWIN + PV + c4);
                    *(f32x4*)(p.out + O_SSMS + (size_t)i * 4) = wf; continue;
                    const u32x2 w = (u32x2){0u, 0u};
#elif DBG_EXPOSE == 1
                    const u32x2 w = *(const u32x2*)(p.PROJ + (size_t)(16384 + (r & 511)) * NWIN + PZ + c4 + ((r >> 9) & 7) * 256);
#elif DBG_EXPOSE == 2
                    const u32x2 w = *(const u32x2*)(p.U + (size_t)(r + 49664) * DM + c4 + 512);
#else
                    const u32x2 w = *(const u32x2*)(p.WIN + (size_t)(PV + (r & 255)) * DM + c4 + (r >> 8) * 4 % 768);
#endif
                    *(f32x4*)(p.out + O_SSMS + (size_t)i * 4) = (f32x4){bf_lo(w.x), bf_hi(w.x), bf_lo(w.y), bf_hi(w.y)};
                }
            }
#else
            if (PM(3)) { rope_phase(p, s); conv_phase(p, s); }
#endif
        } else if (q == 2) {
            if (PM(4)) attn_phase(p, s);
            if (PM(5)) ssdA_phase(p, s);
        } else if (q == 3) {
            if (PM(6)) scan_phase(p, s);
        } else if (q == 4) {
            if (PM(7)) ssdC_phase(p, s);
        } else if (q == 5) {
            g.A = p.Y; g.lda = DI; g.Bt = p.WBRM; g.ldb = DI; g.K = DI; g.nM = nlt; g.nN = DM / BM; g.nmain = nlt; g.abase = 0; g.aextra = 0; g.epi = EPI_F32; g.Fout = p.MIXP; g.slab = s;
            is_gemm = true;
        } else if (q == 6) {
            g.A = p.AO; g.lda = DM; g.Bt = p.WBRA; g.ldb = DM; g.K = DM; g.nM = nlt; g.nN = DM / BM; g.nmain = nlt; g.abase = 0; g.aextra = 0; g.epi = EPI_F32; g.Fout = p.MIXA; g.slab = s;
            is_gemm = true;
        } else if (q == 7) {
            if (PM(9)) mix_phase(p, s);
        } else if (q == 8) {
            g.A = p.MIX; g.lda = DM; g.Bt = p.WO; g.ldb = DM; g.K = DM; g.nM = nlt; g.nN = DM / BM; g.nmain = nlt; g.abase = 0; g.aextra = 0; g.epi = EPI_F32; g.Fout = p.MIXP; g.slab = s;
            is_gemm = true;
        } else {
            if (PM(9)) normres_slab(p, s);
        }
    }
    if (PM(1)) if (is_gemm) {
        for (int rep = 0; rep < nrep; ++rep) {
            if (rep == 1) { g.abase = TP / BM; g.otile0 = SLAB_ROWS / BM; g.nM = TS / BM; g.nmain = g.nM; }
            gemm_phase(p, g);
        }
    }
}

template <int LO, int HI>
__global__ void __launch_bounds__(512) mk_fwd(Params p_arg) {
    cg::grid_group grid = cg::this_grid();
    for (int ph = LO; ph < HI; ++ph) {
        const __attribute__((address_space(4))) Params* pp = (const __attribute__((address_space(4))) Params*)__builtin_amdgcn_kernarg_segment_ptr();
        asm volatile("" : "+s"(pp));
        run_phase(*(const Params*)pp, ph);
        if (ph + 1 < HI && NEED_SYNC(ph)) {
            asm volatile("s_waitcnt vmcnt(0) lgkmcnt(0)" ::: "memory");
            __builtin_amdgcn_fence(__ATOMIC_RELEASE, "agent");
            grid.sync();
            __builtin_amdgcn_fence(__ATOMIC_ACQUIRE, "agent");
        }
    }
}

static inline size_t al256(size_t x) { return (x + 255) & ~(size_t)255; }

extern "C" void kernel_launch(void* const* d_in, const int* in_sizes, int n_in, void* d_out, int out_size, void* d_ws, size_t ws_size, hipStream_t stream) {
    static int grid_blocks = 0;
    if (!grid_blocks) {
        int dev = 0, cus = 0, per_cu = 0;
        (void)hipGetDevice(&dev);
        (void)hipDeviceGetAttribute(&cus, hipDeviceAttributeMultiprocessorCount, dev);
        (void)hipFuncSetAttribute((const void*)mk_fwd<0, PH_GU2>, hipFuncAttributeMaxDynamicSharedMemorySize, LDS_BYTES);
        (void)hipFuncSetAttribute((const void*)mk_fwd<PH_GU2, PH_END>, hipFuncAttributeMaxDynamicSharedMemorySize, LDS_BYTES);
        (void)hipOccupancyMaxActiveBlocksPerMultiprocessor(&per_cu, (const void*)mk_fwd<0, PH_GU2>, 512, LDS_BYTES);
        if (per_cu < 1) per_cu = 1;
        grid_blocks = cus * per_cu;
        (void)hipGetLastError();
    }
    Params p{};
    const float* const* in = (const float* const*)d_in;
    p.x_prompt = in[0]; p.x_sample = in[1]; p.state_conv = in[2]; p.state_ssm = in[3]; p.cache_k = in[4]; p.cache_v = in[5];
    p.ffn1_pre_g = in[6]; p.ffn1_w_gu = in[7]; p.ffn1_w_down = in[8]; p.ffn1_post_g = in[9]; p.mix_pre_g = in[10]; p.w_in = in[11];
    p.conv_w = in[12]; p.conv_b = in[13]; p.dt_bias = in[14]; p.a_log = in[15]; p.d_skip = in[16]; p.m_norm_g = in[17]; p.attn_sink = in[18];
    p.w_br_m = in[19]; p.w_br_a = in[20]; p.w_o = in[21]; p.mix_post_g = in[22]; p.ffn2_pre_g = in[23]; p.ffn2_w_gu = in[24]; p.ffn2_w_down = in[25]; p.ffn2_post_g = in[26];
    p.out = (float*)d_out;
    unsigned char* w = (unsigned char*)d_ws; size_t o = 0;
    auto take = [&](size_t bytes) { unsigned char* r = w + o; o = al256(o + bytes); return r; };
    p.WGU1 = (bf16_t*)take((size_t)2 * DFF * DM * 2); p.WD1 = (bf16_t*)take((size_t)DM * DFF * 2);
    p.WIN = (bf16_t*)take((size_t)NWIN * DM * 2); p.WBRM = (bf16_t*)take((size_t)DM * DI * 2); p.WBRA = (bf16_t*)take((size_t)DM * DM * 2); p.WO = (bf16_t*)take((size_t)DM * DM * 2);
    p.WGU2 = (bf16_t*)take((size_t)2 * DFF * DM * 2); p.WD2 = (bf16_t*)take((size_t)DM * DFF * 2);
    p.KS = (bf16_t*)take((size_t)SB * 160 * 256 * 2); p.VS = (bf16_t*)take((size_t)SB * 160 * 256 * 2);
    p.ROPE = (float2*)take((size_t)SEQ * 8 * 8); p.CDEC = (float*)take((size_t)NST * 32 * 4);
    p.U = (bf16_t*)take((size_t)TT * DM * 2);
    const size_t region = o;
    p.H = (bf16_t*)take((size_t)TT * DFF * 2); p.D = (float*)take((size_t)TT * DM * 4);
    const size_t ffn_end = o;
    o = region;
    p.PROJ = (bf16_t*)take((size_t)LR * NWIN * 2); p.XC = (bf16_t*)take((size_t)LR * CD_ * 2);
    p.SH = (bf16_t*)take((size_t)NST * 32 * 8192 * 2); p.Y = (bf16_t*)take((size_t)LR * DI * 2); p.SSQ = (float*)take((size_t)LR * 32 * 4);
    p.AO = (bf16_t*)take((size_t)LR * DM * 2); p.MIX = (bf16_t*)take((size_t)LR * DM * 2);
    p.QR = (bf16_t*)take((size_t)LR * DM * 2); p.KR = (bf16_t*)take((size_t)LR * 256 * 2);
    p.MIXP = (float*)p.SH;
    p.MIXA = (float*)p.XC;
    const size_t total = o > ffn_end ? o : ffn_end;
    if (total > ws_size) { fprintf(stderr, "kernel_launch: workspace too small: need %zu have %zu\n", total, ws_size); return; }
    void* args[] = {&p};
    hipError_t e = hipLaunchCooperativeKernel((const void*)mk_fwd<0, PH_GU2>, dim3(grid_blocks), dim3(512), args, LDS_BYTES, stream);
    if (e != hipSuccess) fprintf(stderr, "cooperative launch 1 failed: %s (grid %d)\n", hipGetErrorString(e), grid_blocks);
    e = hipLaunchCooperativeKernel((const void*)mk_fwd<PH_GU2, PH_END>, dim3(grid_blocks), dim3(512), args, LDS_BYTES, stream);
    if (e != hipSuccess) fprintf(stderr, "cooperative launch 2 failed: %s (grid %d)\n", hipGetErrorString(e), grid_blocks);
}
```

```cpp
#include <hip/hip_runtime.h>
#include <hip/hip_cooperative_groups.h>
#include <cstdint>
#include <cstdio>
#include <cmath>
namespace cg = cooperative_groups;

#ifndef DBG_YS
#define DBG_YS 0
#endif
#ifndef NO_SAMPLE_OUT
#define NO_SAMPLE_OUT 0
#endif
#ifndef NOSAMPLE
#define NOSAMPLE 0
#endif
#ifndef SIMPLE_ORDER
#define SIMPLE_ORDER 1
#endif
#ifndef SAFE_GEMM
#define SAFE_GEMM 0
#endif
#ifndef DBG_EXPOSE
#define DBG_EXPOSE 0
#endif
#ifndef MULTI_LAUNCH
#define MULTI_LAUNCH 0
#endif

typedef unsigned short bf16_t;
typedef short bf16x8 __attribute__((ext_vector_type(8)));
typedef float f32x4 __attribute__((ext_vector_type(4)));
typedef unsigned u32x4 __attribute__((ext_vector_type(4)));
typedef unsigned u32x2 __attribute__((ext_vector_type(2)));

constexpr int DM = 1024, NB = 8, SEQ = 8192, SB = 16, SL = 32, PAST = 1024;
constexpr int TP = NB * SEQ;
constexpr int TS = SB * SL;
constexpr int TT = TP + TS;
constexpr int DI = 2048, NH = 32, NG = 4, DS = 128, CD_ = 3072, DFF = 2816;
constexpr int NWIN = 8960;
constexpr int SLAB_SEQ = 2;
constexpr int NSLAB = NB / SLAB_SEQ;
constexpr int SLAB_ROWS = SLAB_SEQ * SEQ;
constexpr int LR = SLAB_ROWS + TS;
constexpr int NCH = SEQ / 64;
constexpr int NST = SLAB_SEQ * NCH + SB;
constexpr float EPS = 1e-6f;
constexpr int PZ = 0, PX = 2048, PQ = 5120, PK = 6144, PV = 6400, PG = 6656, PDT = 8704;

constexpr size_t O_Y = 0, O_YS = 67108864, O_CONVP = 67633152, O_SSMP = 67706880, O_KP = 69804032, O_VP = 70066176,
                 O_CONVS = 70328320, O_SSMS = 70475776, O_KS = 74670080, O_VS = 74801152;

struct Params {
    const float *x_prompt, *x_sample, *state_conv, *state_ssm, *cache_k, *cache_v;
    const float *ffn1_pre_g, *ffn1_w_gu, *ffn1_w_down, *ffn1_post_g, *mix_pre_g, *w_in, *conv_w, *conv_b, *dt_bias, *a_log, *d_skip,
        *m_norm_g, *attn_sink, *w_br_m, *w_br_a, *w_o, *mix_post_g, *ffn2_pre_g, *ffn2_w_gu, *ffn2_w_down, *ffn2_post_g;
    float* out;
    bf16_t *WGU1, *WD1, *WIN, *WBRM, *WBRA, *WO, *WGU2, *WD2, *KS, *VS, *U;
    float2* ROPE;
    float* CDEC;
    bf16_t* H;
    float* D;
    bf16_t *PROJ, *XC, *SH, *Y, *AO, *MIX, *QR, *KR;
    float *SSQ, *MIXP, *MIXA;
};

extern __shared__ __attribute__((aligned(16))) unsigned char smem[];
constexpr int LDS_BYTES = 131072;

__device__ __forceinline__ int bid_priv() { int t = blockIdx.x; asm volatile("" : "+s"(t)); return t; }
__device__ __forceinline__ int nblk_priv() { int t = gridDim.x; asm volatile("" : "+s"(t)); return t; }
__device__ __forceinline__ int tid_priv() { int t = threadIdx.x; asm volatile("" : "+v"(t)); return t; }
typedef __bf16 bf16x2_t __attribute__((ext_vector_type(2)));
typedef float f32x2_t __attribute__((ext_vector_type(2)));
__device__ __forceinline__ unsigned pk_bf16(float lo, float hi) { f32x2_t v = {lo, hi}; bf16x2_t b = __builtin_convertvector(v, bf16x2_t); return __builtin_bit_cast(unsigned, b); }
__device__ __forceinline__ float bf_lo(unsigned u) { return __uint_as_float(u << 16); }
__device__ __forceinline__ float bf_hi(unsigned u) { return __uint_as_float(u & 0xffff0000u); }
__device__ __forceinline__ float bf2f(bf16_t h) { return __uint_as_float(((unsigned)h) << 16); }
__device__ __forceinline__ float shx(float v, int m, int lane) { return __int_as_float(__builtin_amdgcn_ds_bpermute((lane ^ m) << 2, __float_as_int(v))); }
__device__ __forceinline__ float shidx(float v, int src, int lane) { return __int_as_float(__builtin_amdgcn_ds_bpermute(src << 2, __float_as_int(v))); }
__device__ __forceinline__ float wave_sum(float v, int lane) {
#pragma unroll
    for (int o = 1; o < 64; o <<= 1) v += shx(v, o, lane);
    return v;
}
__device__ __forceinline__ float san(float v) { return (v == v && fabsf(v) < 1e30f) ? v : 777.f; }
__device__ __forceinline__ float silu_f(float x) { return x / (1.f + __expf(-x)); }
__device__ __forceinline__ float softplus_f(float t) { const float e = __expf(t); return t > 15.f ? t : (t < -15.f ? e : __logf(1.f + e)); }
__device__ __forceinline__ float sigmoid_f(float x) { return 1.f / (1.f + __expf(-x)); }

__device__ __forceinline__ int src_col(int mode, int n) {
    if (mode == 0) return n;
    if (mode == 1) { int pn = n >> 8, j = n & 255; return j < 128 ? pn * 128 + j : DFF + pn * 128 + (j - 128); }
    if (n < 5120) return n;
    if (n < 8704) return n + 32;
    if (n < 8736) return n - 8704 + 5120;
    return -1;
}
__device__ __forceinline__ void tr_jobs(const Params& p) {
    const int bidp = bid_priv(), nblkp = nblk_priv();
    const int tid = tid_priv();
    float* lds = (float*)smem;
    for (int job = 0; job < 8; ++job) {
        const float* W; int K, N, Nout, mode; bf16_t* Wt; const float* ks = nullptr;
        if (job == 0)      { W = p.ffn1_w_gu;   K = DM;  N = 2 * DFF; Wt = p.WGU1; Nout = 2 * DFF; mode = 1; }
        else if (job == 1) { W = p.ffn1_w_down; K = DFF; N = DM;      Wt = p.WD1;  Nout = DM;      mode = 0; }
        else if (job == 2) { W = p.w_in;        K = DM;  N = 8736;    Wt = p.WIN;  Nout = NWIN;    mode = 2; }
        else if (job == 3) { W = p.w_br_m;      K = DI;  N = DM;      Wt = p.WBRM; Nout = DM;      mode = 0; ks = p.m_norm_g; }
        else if (job == 4) { W = p.w_br_a;      K = DM;  N = DM;      Wt = p.WBRA; Nout = DM;      mode = 0; }
        else if (job == 5) { W = p.w_o;         K = DM;  N = DM;      Wt = p.WO;   Nout = DM;      mode = 0; }
        else if (job == 6) { W = p.ffn2_w_gu;   K = DM;  N = 2 * DFF; Wt = p.WGU2; Nout = 2 * DFF; mode = 1; }
        else               { W = p.ffn2_w_down; K = DFF; N = DM;      Wt = p.WD2;  Nout = DM;      mode = 0; }
        const int nnt = Nout / 64, ntile = (K / 64) * nnt;
        for (int t = bidp; t < ntile; t += nblkp) {
            const int nt = t % nnt, kt = t / nnt;
            const int k0 = kt * 64, n0 = nt * 64;
            const int nn = tid & 63, kk0 = tid >> 6;
            const int sc = src_col(mode, n0 + nn);
#pragma unroll
            for (int r = 0; r < 8; ++r) {
                const int kk = kk0 + 8 * r;
                float v = sc >= 0 ? W[(size_t)(k0 + kk) * N + sc] : 0.f;
                if (ks) v *= ks[k0 + kk];
                lds[kk * 65 + nn] = v;
            }
            __syncthreads();
            const int kp = (tid & 31) * 2, nn0 = tid >> 5;
#pragma unroll
            for (int r = 0; r < 4; ++r) {
                const int n2 = nn0 + 16 * r;
                *(unsigned*)(Wt + (size_t)(n0 + n2) * K + k0 + kp) = pk_bf16(lds[kp * 65 + n2], lds[(kp + 1) * 65 + n2]);
            }
            __syncthreads();
        }
    }
}

__device__ __forceinline__ const float* xin_row(const Params& p, int row) {
    return row < TP ? p.x_prompt + (size_t)row * DM : p.x_sample + (size_t)(row - TP) * DM;
}
__device__ __forceinline__ void norm0_phase(const Params& p) {
    const int bidp = bid_priv(), nblkp = nblk_priv();
    const int tidp = tid_priv();
    const int lane = tidp & 63, wv = tidp >> 6;
    for (int row = bidp * 8 + wv; row < TT; row += nblkp * 8) {
        const f32x4* xr = (const f32x4*)xin_row(p, row) + lane;
        f32x4 v[4]; float ss = 0.f;
#pragma unroll
        for (int j = 0; j < 4; ++j) { v[j] = xr[64 * j]; ss += v[j].x * v[j].x + v[j].y * v[j].y + v[j].z * v[j].z + v[j].w * v[j].w; }
        const float rs = rsqrtf(wave_sum(ss, lane) * (1.f / DM) + EPS);
        u32x2* o = (u32x2*)(p.U + (size_t)row * DM) + lane;
#pragma unroll
        for (int j = 0; j < 4; ++j) {
            const f32x4 g = ((const f32x4*)p.ffn1_pre_g)[lane + 64 * j];
            u32x2 w; w.x = pk_bf16(v[j].x * rs * g.x, v[j].y * rs * g.y); w.y = pk_bf16(v[j].z * rs * g.z, v[j].w * rs * g.w);
            o[64 * j] = w;
        }
    }
}
__device__ __forceinline__ void norm_res_row(const float* drow, const float* xold, float* xnew, const float* gpost, float alpha, const float* gpre, bf16_t* xn, int lane) {
    f32x4 d[4], x[4]; float ss = 0.f;
#pragma unroll
    for (int j = 0; j < 4; ++j) { d[j] = ((const f32x4*)drow)[lane + 64 * j]; x[j] = ((const f32x4*)xold)[lane + 64 * j]; ss += d[j].x * d[j].x + d[j].y * d[j].y + d[j].z * d[j].z + d[j].w * d[j].w; }
    const float rs = rsqrtf(wave_sum(ss, lane) * (1.f / DM) + EPS) * alpha;
    float s2 = 0.f;
#pragma unroll
    for (int j = 0; j < 4; ++j) {
        const f32x4 g = ((const f32x4*)gpost)[lane + 64 * j];
        x[j].x += d[j].x * rs * g.x; x[j].y += d[j].y * rs * g.y; x[j].z += d[j].z * rs * g.z; x[j].w += d[j].w * rs * g.w;
        x[j].x = san(x[j].x); x[j].y = san(x[j].y); x[j].z = san(x[j].z); x[j].w = san(x[j].w);
        ((f32x4*)xnew)[lane + 64 * j] = x[j];
        s2 += x[j].x * x[j].x + x[j].y * x[j].y + x[j].z * x[j].z + x[j].w * x[j].w;
    }
    if (gpre) {
        const float r2 = rsqrtf(wave_sum(s2, lane) * (1.f / DM) + EPS);
#pragma unroll
        for (int j = 0; j < 4; ++j) {
            const f32x4 g = ((const f32x4*)gpre)[lane + 64 * j];
            u32x2 w; w.x = pk_bf16(x[j].x * r2 * g.x, x[j].y * r2 * g.y); w.y = pk_bf16(x[j].z * r2 * g.z, x[j].w * r2 * g.w);
            ((u32x2*)xn)[lane + 64 * j] = w;
        }
    }
}

__device__ __forceinline__ int l2g_row(int s, int lrow) { return lrow < SLAB_ROWS ? s * SLAB_ROWS + lrow : TP + (lrow - SLAB_ROWS); }

constexpr int BM = 256, BK = 64, HALF = 128, HT = HALF * BK;
__device__ __forceinline__ int lds_byte(int r, int c) {
    int st = (r >> 4) * 2 + (c >> 5), rr = r & 15, cc = c & 31, ob = rr * 64 + cc * 2;
    return st * 1024 + (ob ^ (((ob >> 9) & 1) << 5));
}
__device__ __forceinline__ void stage_rc(int b, int& R, int& C) {
    int st = b / 1024, sb = b % 1024, swz = sb ^ (((sb >> 9) & 1) << 5);
    R = (st >> 1) * 16 + swz / 64; C = (st & 1) * 32 + (swz % 64) / 2;
}

#define LAS __attribute__((address_space(3)))
enum { EPI_SWIGLU = 0, EPI_F32 = 1, EPI_BF16 = 2 };
struct GemmDesc {
    const bf16_t* A; int lda; const bf16_t* Bt; int ldb; int K;
    int nM, nN;
    int nmain, abase, aextra;
    int epi; int slab;
    bf16_t* Hout; float* Fout; int ldc; int otile0;
};

__device__ __forceinline__ void epi_swiglu(const Params& p, const GemmDesc& g, const f32x4 (&acc)[2][2][4][2], int pm, int pn, int tid) {
    const int wid = tid >> 6, lane = tid & 63, wr = wid >> 2, wc = wid & 3, fr = lane & 15, fq = lane >> 4;
#pragma unroll
    for (int ai = 0; ai < 2; ++ai)
#pragma unroll
        for (int m = 0; m < 4; ++m) {
            const size_t row = (size_t)pm * BM + ai * HALF + wr * 64 + m * 16 + fr;
#pragma unroll
            for (int n = 0; n < 2; ++n) {
                const f32x4 ga = acc[ai][0][m][n], up = acc[ai][1][m][n];
                u32x2 w; w.x = pk_bf16(silu_f(ga.x) * up.x, silu_f(ga.y) * up.y); w.y = pk_bf16(silu_f(ga.z) * up.z, silu_f(ga.w) * up.w);
                *(u32x2*)(g.Hout + row * DFF + pn * 128 + wc * 32 + n * 16 + fq * 4) = w;
            }
        }
}
__device__ __forceinline__ void epi_f32(const GemmDesc& g, const f32x4 (&acc)[2][2][4][2], int pm, int pn, int tid) {
    const int wid = tid >> 6, lane = tid & 63, wr = wid >> 2, wc = wid & 3, fr = lane & 15, fq = lane >> 4;
#pragma unroll
    for (int ai = 0; ai < 2; ++ai)
#pragma unroll
        for (int m = 0; m < 4; ++m) {
            const size_t row = (size_t)pm * BM + ai * HALF + wr * 64 + m * 16 + fr;
#pragma unroll
            for (int bj = 0; bj < 2; ++bj)
#pragma unroll
                for (int n = 0; n < 2; ++n)
                    *(f32x4*)(g.Fout + row * (g.ldc ? g.ldc : DM) + pn * BM + bj * HALF + wc * 32 + n * 16 + fq * 4) = acc[ai][bj][m][n];
        }
}
__device__ __forceinline__ void st_bf16x4(bf16_t* dst, f32x4 v) { u32x2 w; w.x = pk_bf16(v.x, v.y); w.y = pk_bf16(v.z, v.w); *(u32x2*)dst = w; }

__device__ __forceinline__ void epi_bf16(const GemmDesc& g, const f32x4 (&acc)[2][2][4][2], int pm, int pn, int tid) {
    const int wid = tid >> 6, lane = tid & 63, wr = wid >> 2, wc = wid & 3, fr = lane & 15, fq = lane >> 4;
#pragma unroll
    for (int ai = 0; ai < 2; ++ai)
#pragma unroll
        for (int m = 0; m < 4; ++m) {
            const size_t row = (size_t)pm * BM + ai * HALF + wr * 64 + m * 16 + fr;
#pragma unroll
            for (int bj = 0; bj < 2; ++bj)
#pragma unroll
                for (int n = 0; n < 2; ++n)
                    st_bf16x4(g.Hout + row * NWIN + pn * BM + bj * HALF + wc * 32 + n * 16 + fq * 4, acc[ai][bj][m][n]);
        }
}

__device__ __forceinline__ int tile_order(int i, int nM, int nN, int& pm, int& pn, int bid, int nblk) {
#if SIMPLE_ORDER
    { const int L = i * nblk + bid; if (L >= nM * nN) return 0; pm = L % nM; pn = L / nM; return 1; }
#endif
    const int ngroups = (nM + 7) >> 3, g8 = 8 * nN, ntot = ngroups * g8, chunk = (ntot + 7) >> 3;
    const int x = bid & 7, j = bid >> 3, nj = nblk >> 3;
    const int v = i * nj + j;
    if (v >= chunk) return 0;
    const int T = x * chunk + v;
    if (T >= ntot) return 0;
    int group;
    if (nN == 22) group = T / 176; else if (nN == 4) group = T / 32; else if (nN == 35) group = T / 280; else group = T / g8;
    const int within = T - group * g8;
    pm = group * 8 + (within & 7); pn = within >> 3;
    return pm < nM ? 1 : 2;
}

__device__ __forceinline__ void gemm_phase(const Params& p, const GemmDesc& g) {
    const int bidp = bid_priv(), nblkp = nblk_priv();
    LAS unsigned char* lds = (LAS unsigned char*)smem;
    const int tid = tid_priv(), wid = __builtin_amdgcn_readfirstlane(tid >> 6), lane = tid & 63, wr = wid >> 2, wc = wid & 3, fr = lane & 15, fq = lane >> 4;
    const int K = g.K, nt = K / BK;
    constexpr int HTB = HALF * BK * 2;
    unsigned voff[2];
#pragma unroll
    for (int i = 0; i < 2; ++i) { int R, C; stage_rc(tid * 16 + i * 8192, R, C); voff[i] = (unsigned)(R * K + C) * 2u; }
    const size_t kstep = (size_t)(BK * 2);
    const size_t hstep = (size_t)HALF * K * 2;
    const size_t tstep = 2 * hstep;
    const unsigned ldsw = (unsigned)wid * 1024u;
    const int aoff = lds_byte(wr * 64 + fr, fq * 8), boff = lds_byte(wc * 32 + fr, fq * 8);
#define PG8_SA(b, h) (((b) * 2 + (h)) * HTB)
#define PG8_SB(b, h) ((4 + (b) * 2 + (h)) * HTB)
#define PG8_STAGE(bufoff, gbase) do { _Pragma("unroll") for (int _i = 0; _i < 2; ++_i) \
        __builtin_amdgcn_global_load_lds((const unsigned*)((const char*)(gbase) + voff[_i]), (LAS unsigned*)(lds + (bufoff) + ldsw + _i * 8192), 16, 0, 0); } while (0)
#define PG8_LDA(dst, b, h) do { _Pragma("unroll") for (int m = 0; m < 4; ++m) _Pragma("unroll") for (int k = 0; k < 2; ++k) dst[m][k] = *(const LAS bf16x8*)(lds + PG8_SA(b, h) + aoff + m * 2048 + k * 1024); } while (0)
#define PG8_LDB(dst, b, h) do { _Pragma("unroll") for (int n = 0; n < 2; ++n) _Pragma("unroll") for (int k = 0; k < 2; ++k) dst[n][k] = *(const LAS bf16x8*)(lds + PG8_SB(b, h) + boff + n * 2048 + k * 1024); } while (0)
#define PG8_MMA(ai, bj, At, Bt) do { __builtin_amdgcn_s_setprio(1); _Pragma("unroll") for (int m = 0; m < 4; ++m) _Pragma("unroll") for (int n = 0; n < 2; ++n) _Pragma("unroll") for (int k = 0; k < 2; ++k) \
        acc[ai][bj][m][n] = __builtin_amdgcn_mfma_f32_16x16x32_bf16(Bt[n][k], At[m][k], acc[ai][bj][m][n], 0, 0, 0); __builtin_amdgcn_s_setprio(0); } while (0)
#define PG8_WAIT_V(n) asm volatile("s_waitcnt vmcnt(" #n ")" ::: "memory")
#define PG8_WAIT_L(n) asm volatile("s_waitcnt lgkmcnt(" #n ")" ::: "memory")
#define PG8_BAR __builtin_amdgcn_s_barrier()
#define PG8_SCHED __builtin_amdgcn_sched_barrier(0)
    int pm, pn;
    f32x4 acc[2][2][4][2];
    bf16x8 At[4][2], B0[2][2], B1[2][2];
    __syncthreads();
#define STAGE_TILE(b, kt) do { const char* _a = cA + (size_t)(kt) * kstep; const char* _b = cB + (size_t)(kt) * kstep; \
        PG8_STAGE(PG8_SB(b, 0), _b); PG8_STAGE(PG8_SA(b, 0), _a); PG8_STAGE(PG8_SB(b, 1), _b + hstep); PG8_STAGE(PG8_SA(b, 1), _a + hstep); } while (0)
    for (int ui = 0;; ++ui) {
        const int tor = tile_order(ui, g.nM, g.nN, pm, pn, bidp, nblkp);
        if (tor == 0) break;
        if (tor == 2) continue;
#pragma unroll
        for (int a = 0; a < 2; ++a)
#pragma unroll
            for (int b = 0; b < 2; ++b)
#pragma unroll
                for (int m = 0; m < 4; ++m)
#pragma unroll
                    for (int n = 0; n < 2; ++n) acc[a][b][m][n] = (f32x4){0.f, 0.f, 0.f, 0.f};
        const char* cA = (const char*)g.A + (size_t)(g.abase + pm) * tstep;
        const char* cB = (const char*)g.Bt + (size_t)pn * tstep;
        PG8_WAIT_V(0);
        PG8_BAR;
#if SAFE_GEMM
        for (int t = 0; t < nt; ++t) {
            STAGE_TILE(0, t);
            PG8_WAIT_V(0); PG8_BAR;
            PG8_LDB(B0, 0, 0); PG8_LDB(B1, 0, 1); PG8_LDA(At, 0, 0); PG8_WAIT_L(0);
            PG8_MMA(0, 0, At, B0); PG8_MMA(0, 1, At, B1);
            PG8_LDA(At, 0, 1); PG8_WAIT_L(0); PG8_BAR;
            PG8_MMA(1, 0, At, B0); PG8_MMA(1, 1, At, B1);
        }
#else
        STAGE_TILE(0, 0);
        for (int t = 0; t < nt; t += 2) {
            STAGE_TILE(1, t + 1);
            PG8_WAIT_V(8); PG8_BAR;
            PG8_LDB(B0, 0, 0); PG8_LDB(B1, 0, 1); PG8_LDA(At, 0, 0); PG8_WAIT_L(0);
            PG8_MMA(0, 0, At, B0); PG8_MMA(0, 1, At, B1);
            PG8_LDA(At, 0, 1); PG8_WAIT_L(0); PG8_BAR;
            if (t + 2 < nt) STAGE_TILE(0, t + 2);
            PG8_MMA(1, 0, At, B0); PG8_MMA(1, 1, At, B1);
            if (t + 2 < nt) PG8_WAIT_V(8); else PG8_WAIT_V(0);
            PG8_BAR;
            PG8_LDB(B0, 1, 0); PG8_LDB(B1, 1, 1); PG8_LDA(At, 1, 0); PG8_WAIT_L(0);
            PG8_MMA(0, 0, At, B0); PG8_MMA(0, 1, At, B1);
            PG8_LDA(At, 1, 1); PG8_WAIT_L(0); PG8_BAR;
            PG8_MMA(1, 0, At, B0); PG8_MMA(1, 1, At, B1);
        }
#endif
        if (g.epi == EPI_SWIGLU) epi_swiglu(p, g, acc, pm + g.otile0, pn, tid);
        else if (g.epi == EPI_F32) epi_f32(g, acc, pm + g.otile0, pn, tid);
        else if (!(DBG_EXPOSE == 6 && pm >= 64)) epi_bf16(g, acc, pm + g.otile0, pn, tid);
    }
    PG8_WAIT_V(0);
    PG8_BAR;
}

__device__ __forceinline__ void prep_misc(const Params& p) {
    const int bidp = bid_priv(), nblkp = nblk_priv();
    const int tidp = tid_priv();
    const int gt = bidp * 512 + tidp, ng = nblkp * 512;
    for (int i = gt; i < SB * 128 * 64; i += ng) {
        const int c4 = i & 63, r = (i >> 6) & 127, sb = i >> 13;
        const f32x4 k = ((const f32x4*)p.cache_k)[i], v = ((const f32x4*)p.cache_v)[i];
        st_bf16x4(p.KS + ((size_t)sb * 160 + r) * 256 + c4 * 4, k);
        st_bf16x4(p.VS + ((size_t)sb * 160 + r) * 256 + c4 * 4, v);
    }
}

struct RopeTab { float c[8], s[8]; };
__device__ __forceinline__ void rope_make(const Params& p, int pos, RopeTab& t) {
    const double dp = (double)pos * 0.15915494309189535;
#pragma unroll
    for (int i = 0; i < 8; ++i) {
        constexpr double INVF[8] = {1.0, 0.19392274474868576, 0.03760603093086393, 0.007292664737217109, 0.001414213562373095, 0.0002742481756762073, 5.318295896944988e-05, 1.031338537721246e-05};
        const double r = dp * INVF[i];
        const float fr_ = (float)(r - floor(r));
        float u = fr_ - 0.5f;
        float sgn = -1.f;
        if (u > 0.25f) { u = 0.5f - u; } else if (u < -0.25f) { u = -0.5f - u; } else { sgn = 1.f; }
        const float v = 6.283185307179586f * u, v2 = v * v;
        const float sp = v * (1.f + v2 * (-1.6666667e-1f + v2 * (8.3333333e-3f + v2 * (-1.9841270e-4f + v2 * (2.7557319e-6f + v2 * -2.5052108e-8f)))));
        const float cp = 1.f + v2 * (-0.5f + v2 * (4.1666667e-2f + v2 * (-1.3888889e-3f + v2 * (2.4801587e-5f + v2 * (-2.7557319e-7f + v2 * 2.0876757e-9f)))));
        t.s[i] = -sp; t.c[i] = (sgn > 0.f) ? -cp : cp;
    }
}
__device__ __forceinline__ void rope16(float (&x)[16], const RopeTab& t) {
#pragma unroll
    for (int i = 0; i < 8; ++i) {
        const float a0 = x[i], b0 = x[i + 8];
        x[i] = a0 * t.c[i] - b0 * t.s[i]; x[i + 8] = b0 * t.c[i] + a0 * t.s[i];
    }
}
__device__ __forceinline__ void rope_bf16_inplace(bf16_t* ptr, const RopeTab& tab) {
    const u32x4 a = *(const u32x4*)ptr, b = *(const u32x4*)(ptr + 8);
    float x[16];
    x[0] = bf_lo(a.x); x[1] = bf_hi(a.x); x[2] = bf_lo(a.y); x[3] = bf_hi(a.y); x[4] = bf_lo(a.z); x[5] = bf_hi(a.z); x[6] = bf_lo(a.w); x[7] = bf_hi(a.w);
    x[8] = bf_lo(b.x); x[9] = bf_hi(b.x); x[10] = bf_lo(b.y); x[11] = bf_hi(b.y); x[12] = bf_lo(b.z); x[13] = bf_hi(b.z); x[14] = bf_lo(b.w); x[15] = bf_hi(b.w);
    rope16(x, tab);
    u32x4 oa, ob;
    oa.x = pk_bf16(x[0], x[1]); oa.y = pk_bf16(x[2], x[3]); oa.z = pk_bf16(x[4], x[5]); oa.w = pk_bf16(x[6], x[7]);
    ob.x = pk_bf16(x[8], x[9]); ob.y = pk_bf16(x[10], x[11]); ob.z = pk_bf16(x[12], x[13]); ob.w = pk_bf16(x[14], x[15]);
    *(u32x4*)ptr = oa; *(u32x4*)(ptr + 8) = ob;
}
__device__ __forceinline__ void rope_f32_inplace(float* ptr, const RopeTab& tab) {
    float x[16];
#pragma unroll
    for (int q = 0; q < 4; ++q) { const f32x4 v = ((const f32x4*)ptr)[q]; x[4 * q] = v.x; x[4 * q + 1] = v.y; x[4 * q + 2] = v.z; x[4 * q + 3] = v.w; }
    rope16(x, tab);
#pragma unroll
    for (int q = 0; q < 4; ++q) ((f32x4*)ptr)[q] = (f32x4){x[4 * q], x[4 * q + 1], x[4 * q + 2], x[4 * q + 3]};
}
__device__ __forceinline__ void cp64_bf16_f32(const bf16_t* s, bf16_t* dbf, float* df) {
#pragma unroll
    for (int q = 0; q < 8; ++q) {
        const u32x4 a = *(const u32x4*)(s + q * 8);
        if (dbf) *(u32x4*)(dbf + q * 8) = a;
        if (df) { ((f32x4*)df)[2 * q] = (f32x4){bf_lo(a.x), bf_hi(a.x), bf_lo(a.y), bf_hi(a.y)}; ((f32x4*)df)[2 * q + 1] = (f32x4){bf_lo(a.z), bf_hi(a.z), bf_lo(a.w), bf_hi(a.w)}; }
    }
}
__device__ __forceinline__ void rope64(const bf16_t* s, const RopeTab& tab, bf16_t* dbf, float* df) {
    const u32x4 a = *(const u32x4*)s, b = *(const u32x4*)(s + 8);
    float x[16];
    x[0] = bf_lo(a.x); x[1] = bf_hi(a.x); x[2] = bf_lo(a.y); x[3] = bf_hi(a.y); x[4] = bf_lo(a.z); x[5] = bf_hi(a.z); x[6] = bf_lo(a.w); x[7] = bf_hi(a.w);
    x[8] = bf_lo(b.x); x[9] = bf_hi(b.x); x[10] = bf_lo(b.y); x[11] = bf_hi(b.y); x[12] = bf_lo(b.z); x[13] = bf_hi(b.z); x[14] = bf_lo(b.w); x[15] = bf_hi(b.w);
    rope16(x, tab);
    u32x4 oa, ob;
    oa.x = pk_bf16(x[0], x[1]); oa.y = pk_bf16(x[2], x[3]); oa.z = pk_bf16(x[4], x[5]); oa.w = pk_bf16(x[6], x[7]);
    ob.x = pk_bf16(x[8], x[9]); ob.y = pk_bf16(x[10], x[11]); ob.z = pk_bf16(x[12], x[13]); ob.w = pk_bf16(x[14], x[15]);
    *(u32x4*)dbf = oa; *(u32x4*)(dbf + 8) = ob;
    if (df) {
#pragma unroll
        for (int q = 0; q < 4; ++q) ((f32x4*)df)[q] = (f32x4){x[4 * q], x[4 * q + 1], x[4 * q + 2], x[4 * q + 3]};
    }
#pragma unroll
    for (int q = 2; q < 8; ++q) {
        const u32x4 c = *(const u32x4*)(s + q * 8);
        *(u32x4*)(dbf + q * 8) = c;
        if (df) { ((f32x4*)df)[2 * q] = (f32x4){bf_lo(c.x), bf_hi(c.x), bf_lo(c.y), bf_hi(c.y)}; ((f32x4*)df)[2 * q + 1] = (f32x4){bf_lo(c.z), bf_hi(c.z), bf_lo(c.w), bf_hi(c.w)}; }
    }
}
__device__ __forceinline__ void rope_phase(const Params& p, int slab) {
    const int tidp = tid_priv();
    const int bidp = bid_priv(), nblkp = nblk_priv();
    const int gt = bidp * 512 + tidp, ng = nblkp * 512;
    const int nrow = (slab == 0 && !NOSAMPLE) ? LR : SLAB_ROWS;
    for (int idx = gt; idx < nrow * 20; idx += ng) {
        const int lrow = idx / 20, slot = idx - lrow * 20;
        const bool is_sample = lrow >= SLAB_ROWS;
        int sq, l, pos;
        if (!is_sample) { const int grow = slab * SLAB_ROWS + lrow; sq = grow >> 13; l = grow & (SEQ - 1); pos = l; }
        else { const int srow = lrow - SLAB_ROWS; sq = srow >> 5; l = srow & 31; pos = PAST + l; }
        RopeTab tab; rope_make(p, pos, tab);
        const bf16_t* prow = p.PROJ + (size_t)lrow * NWIN;
        if (slot < 16) {
            rope64(prow + PQ + slot * 64, tab, p.QR + (size_t)lrow * DM + slot * 64, nullptr);
        } else {
            const int kh = slot - 16;
            const bf16_t* kp = prow + PK + kh * 64; const bf16_t* vp = prow + PV + kh * 64;
            if (!is_sample) {
                float* kf = nullptr; float* vf = nullptr;
#ifndef NO_KV_OUT
#define NO_KV_OUT 0
#endif
                if (!NO_KV_OUT && l >= SEQ - 128) { const size_t o = ((size_t)sq * 128 + (l - (SEQ - 128))) * 256 + kh * 64; kf = p.out + O_KP + o; vf = p.out + O_VP + o; }
                rope64(kp, tab, p.KR + (size_t)lrow * 256 + kh * 64, kf);
                if (vf) cp64_bf16_f32(vp, nullptr, vf);
            } else {
                const size_t o = ((size_t)sq * SL + l) * 256 + kh * 64, so = ((size_t)sq * 160 + 128 + l) * 256 + kh * 64;
                rope64(kp, tab, p.KS + so, (NO_KV_OUT || NO_SAMPLE_OUT) ? nullptr : p.out + O_KS + o);
                cp64_bf16_f32(vp, p.VS + so, (NO_KV_OUT || NO_SAMPLE_OUT) ? nullptr : p.out + O_VS + o);
            }
        }
    }
}

__device__ __forceinline__ void conv_phase(const Params& p, int slab) {
    const int bidp = bid_priv(), nblkp = nblk_priv();
    const int tidp = tid_priv();
    const int nseg = (slab == 0 && !NOSAMPLE) ? (LR / 32) : (SLAB_ROWS / 32);
    for (int sg = bidp; sg < nseg; sg += nblkp) {
        const int lr0 = sg * 32;
        const bool is_sample = lr0 >= SLAB_ROWS;
        const bool seq_start = is_sample ? true : ((lr0 & (SEQ - 1)) == 0);
        const int sb = is_sample ? (lr0 - SLAB_ROWS) >> 5 : 0;
        for (int u = tidp; u < 384 * 4; u += 512) {
            const int cg8 = u % 384, rb = u / 384;
            const int c = cg8 * 8, r0 = lr0 + rb * 8;
            float w[4][8], bias[8];
#pragma unroll
            for (int j = 0; j < 4; ++j) { const f32x4 a = *(const f32x4*)(p.conv_w + j * CD_ + c), b = *(const f32x4*)(p.conv_w + j * CD_ + c + 4);
                w[j][0] = a.x; w[j][1] = a.y; w[j][2] = a.z; w[j][3] = a.w; w[j][4] = b.x; w[j][5] = b.y; w[j][6] = b.z; w[j][7] = b.w; }
            { const f32x4 a = *(const f32x4*)(p.conv_b + c), b = *(const f32x4*)(p.conv_b + c + 4);
              bias[0] = a.x; bias[1] = a.y; bias[2] = a.z; bias[3] = a.w; bias[4] = b.x; bias[5] = b.y; bias[6] = b.z; bias[7] = b.w; }
            float h0[8], h1[8], h2[8];
            if (rb == 0 && seq_start) {
                if (is_sample) {
                    const float* sc = p.state_conv + (size_t)sb * 3 * CD_ + c;
#pragma unroll
                    for (int e = 0; e < 8; ++e) { h0[e] = sc[e]; h1[e] = sc[CD_ + e]; h2[e] = sc[2 * CD_ + e]; }
                } else {
#pragma unroll
                    for (int e = 0; e < 8; ++e) { h0[e] = 0.f; h1[e] = 0.f; h2[e] = 0.f; }
                }
            } else {
                const u32x4 a0 = *(const u32x4*)(p.PROJ + (size_t)(r0 - 3) * NWIN + PX + c), a1 = *(const u32x4*)(p.PROJ + (size_t)(r0 - 2) * NWIN + PX + c), a2 = *(const u32x4*)(p.PROJ + (size_t)(r0 - 1) * NWIN + PX + c);
                h0[0] = bf_lo(a0.x); h0[1] = bf_hi(a0.x); h0[2] = bf_lo(a0.y); h0[3] = bf_hi(a0.y); h0[4] = bf_lo(a0.z); h0[5] = bf_hi(a0.z); h0[6] = bf_lo(a0.w); h0[7] = bf_hi(a0.w);
                h1[0] = bf_lo(a1.x); h1[1] = bf_hi(a1.x); h1[2] = bf_lo(a1.y); h1[3] = bf_hi(a1.y); h1[4] = bf_lo(a1.z); h1[5] = bf_hi(a1.z); h1[6] = bf_lo(a1.w); h1[7] = bf_hi(a1.w);
                h2[0] = bf_lo(a2.x); h2[1] = bf_hi(a2.x); h2[2] = bf_lo(a2.y); h2[3] = bf_hi(a2.y); h2[4] = bf_lo(a2.z); h2[5] = bf_hi(a2.z); h2[6] = bf_lo(a2.w); h2[7] = bf_hi(a2.w);
            }
#pragma unroll
            for (int rr = 0; rr < 8; ++rr) {
                const u32x4 a = *(const u32x4*)(p.PROJ + (size_t)(r0 + rr) * NWIN + PX + c);
                float x[8]; x[0] = bf_lo(a.x); x[1] = bf_hi(a.x); x[2] = bf_lo(a.y); x[3] = bf_hi(a.y); x[4] = bf_lo(a.z); x[5] = bf_hi(a.z); x[6] = bf_lo(a.w); x[7] = bf_hi(a.w);
                {
                    const int lr = r0 + rr;
                    int so = -1;
                    if (is_sample) { const int l = (lr - SLAB_ROWS) & 31; if (!NO_SAMPLE_OUT && l >= SL - 3) so = (int)O_CONVS + (sb * 3 + (l - (SL - 3))) * CD_ + c; }
                    else { const int grow = slab * SLAB_ROWS + lr, l = grow & (SEQ - 1); if (l >= SEQ - 3) so = (int)O_CONVP + ((grow >> 13) * 3 + (l - (SEQ - 3))) * CD_ + c; }
#ifndef NO_CONV_OUT
#define NO_CONV_OUT 0
#endif
                    if (!NO_CONV_OUT && so >= 0) { *(f32x4*)(p.out + so) = (f32x4){x[0], x[1], x[2], x[3]}; *(f32x4*)(p.out + so + 4) = (f32x4){x[4], x[5], x[6], x[7]}; }
                }
                float o[8];
#pragma unroll
                for (int e = 0; e < 8; ++e) { o[e] = silu_f(bias[e] + w[0][e] * h0[e] + w[1][e] * h1[e] + w[2][e] * h2[e] + w[3][e] * x[e]); h0[e] = h1[e]; h1[e] = h2[e]; h2[e] = x[e]; }
                u32x4 ov; ov.x = pk_bf16(o[0], o[1]); ov.y = pk_bf16(o[2], o[3]); ov.z = pk_bf16(o[4], o[5]); ov.w = pk_bf16(o[6], o[7]);
                *(u32x4*)(p.XC + (size_t)(r0 + rr) * CD_ + c) = ov;
            }
        }
    }
}

constexpr int KL_STRIDE = 72, VT_STRIDE = 200;
__device__ __forceinline__ void attn_phase(const Params& p, int slab) {
    const int bidp = bid_priv(), nblkp = nblk_priv();
    const int tidp = tid_priv();
    bf16_t* Kl = (bf16_t*)smem;
    bf16_t* Vt = (bf16_t*)(smem + 192 * KL_STRIDE * 2);
    const int tid = tidp, wid = tid >> 6, lane = tid & 63, fr = lane & 15, fq = lane >> 4;
    const int nprompt = SLAB_SEQ * NCH * 4;
    const int nitem = nprompt + ((slab == 0 && !NOSAMPLE) ? SB * 4 : 0);
    for (int it = bidp; it < nitem; it += nblkp) {
        int kh, nq, nvalid, qrow0, kvs, vvs; const bf16_t *kb0, *kb1, *kb2, *vb0, *vb1, *vb2;
        if (it < nprompt) {
            kh = it & 3; const int c = (it >> 2) & (NCH - 1), sq = it >> 9;
            nq = 64; nvalid = 64 * (c + 1 < 3 ? c + 1 : 3); qrow0 = sq * SEQ + c * 64; kvs = 256; vvs = NWIN;
            const int c1 = c >= 1 ? c - 1 : 0, c2 = c >= 2 ? c - 2 : 0;
            kb0 = p.KR + (size_t)(sq * SEQ + c * 64) * 256; kb1 = p.KR + (size_t)(sq * SEQ + c1 * 64) * 256; kb2 = p.KR + (size_t)(sq * SEQ + c2 * 64) * 256;
            vb0 = p.PROJ + (size_t)(sq * SEQ + c * 64) * NWIN + PV; vb1 = p.PROJ + (size_t)(sq * SEQ + c1 * 64) * NWIN + PV; vb2 = p.PROJ + (size_t)(sq * SEQ + c2 * 64) * NWIN + PV;
        } else {
            const int j = it - nprompt; kh = j & 3; const int sb = j >> 2;
            nq = 32; nvalid = 160; qrow0 = SLAB_ROWS + sb * SL; kvs = 256; vvs = 256;
            kb0 = p.KS + (size_t)sb * 160 * 256; kb1 = kb0 + 64 * 256; kb2 = kb0 + 128 * 256;
            vb0 = p.VS + (size_t)sb * 160 * 256; vb1 = vb0 + 64 * 256; vb2 = vb0 + 128 * 256;
        }
        __syncthreads();
#pragma unroll
        for (int r = 0; r < 3; ++r) {
            const int idx = tid + 512 * r, slot = idx >> 3, seg = idx & 7;
            u32x4 kv = (u32x4){0u, 0u, 0u, 0u}, vv = (u32x4){0u, 0u, 0u, 0u};
            if (slot < nvalid) {
                const int blk = slot >> 6, rr = slot & 63;
                const bf16_t* kp = (blk == 0 ? kb0 : (blk == 1 ? kb1 : kb2)) + (size_t)rr * kvs + kh * 64 + seg * 8;
                const bf16_t* vp = (blk == 0 ? vb0 : (blk == 1 ? vb1 : vb2)) + (size_t)rr * vvs + kh * 64 + seg * 8;
                kv = *(const u32x4*)kp; vv = *(const u32x4*)vp;
            }
            *(u32x4*)(Kl + slot * KL_STRIDE + seg * 8) = kv;
            bf16_t* vd = Vt + (seg * 8) * VT_STRIDE + slot;
            vd[0 * VT_STRIDE] = (bf16_t)(vv.x & 0xffff); vd[1 * VT_STRIDE] = (bf16_t)(vv.x >> 16);
            vd[2 * VT_STRIDE] = (bf16_t)(vv.y & 0xffff); vd[3 * VT_STRIDE] = (bf16_t)(vv.y >> 16);
            vd[4 * VT_STRIDE] = (bf16_t)(vv.z & 0xffff); vd[5 * VT_STRIDE] = (bf16_t)(vv.z >> 16);
            vd[6 * VT_STRIDE] = (bf16_t)(vv.w & 0xffff); vd[7 * VT_STRIDE] = (bf16_t)(vv.w >> 16);
        }
        __syncthreads();
        const int rep = wid >> 1, th = wid & 1;
        if (th * 32 < nq) {
            const int h = kh * 4 + rep;
            const int ntv = nvalid >> 4;
            bf16x8 qf[2][2];
#pragma unroll
            for (int mt = 0; mt < 2; ++mt)
#pragma unroll
                for (int ks = 0; ks < 2; ++ks)
                    qf[mt][ks] = *(const bf16x8*)(p.QR + (size_t)(qrow0 + th * 32 + mt * 16 + fr) * DM + h * 64 + ks * 32 + fq * 8);
            f32x4 sacc[12][2];
#pragma unroll
            for (int nt = 0; nt < 12; ++nt) {
                sacc[nt][0] = (f32x4){0.f, 0.f, 0.f, 0.f}; sacc[nt][1] = (f32x4){0.f, 0.f, 0.f, 0.f};
                if (nt < ntv) {
#pragma unroll
                    for (int ks = 0; ks < 2; ++ks) {
                        const bf16x8 kf = *(const bf16x8*)(Kl + (nt * 16 + fr) * KL_STRIDE + ks * 32 + fq * 8);
                        sacc[nt][0] = __builtin_amdgcn_mfma_f32_16x16x32_bf16(kf, qf[0][ks], sacc[nt][0], 0, 0, 0);
                        sacc[nt][1] = __builtin_amdgcn_mfma_f32_16x16x32_bf16(kf, qf[1][ks], sacc[nt][1], 0, 0, 0);
                    }
                }
            }
#pragma unroll
            for (int nt = 0; nt < 12; ++nt) { sacc[nt][0] = sacc[nt][0] * 0.125f; sacc[nt][1] = sacc[nt][1] * 0.125f; }
            const float sink = p.attn_sink[h];
            float inv[2];
#pragma unroll
            for (int mt = 0; mt < 2; ++mt) {
                float mx = sink;
#pragma unroll
                for (int nt = 0; nt < 12; ++nt) if (nt < ntv) mx = fmaxf(mx, fmaxf(fmaxf(sacc[nt][mt].x, sacc[nt][mt].y), fmaxf(sacc[nt][mt].z, sacc[nt][mt].w)));
                mx = fmaxf(mx, shx(mx, 16, lane)); mx = fmaxf(mx, shx(mx, 32, lane));
                float sm = 0.f;
#pragma unroll
                for (int nt = 0; nt < 12; ++nt) {
                    if (nt < ntv) {
                        f32x4 e; e.x = __expf(sacc[nt][mt].x - mx); e.y = __expf(sacc[nt][mt].y - mx); e.z = __expf(sacc[nt][mt].z - mx); e.w = __expf(sacc[nt][mt].w - mx);
                        sacc[nt][mt] = e; sm += (e.x + e.y) + (e.z + e.w);
                    }
                }
                sm += shx(sm, 16, lane); sm += shx(sm, 32, lane);
                inv[mt] = 1.f / (sm + __expf(sink - mx));
            }
            f32x4 oacc[4][2];
#pragma unroll
            for (int dt = 0; dt < 4; ++dt) { oacc[dt][0] = (f32x4){0.f, 0.f, 0.f, 0.f}; oacc[dt][1] = (f32x4){0.f, 0.f, 0.f, 0.f}; }
#pragma unroll
            for (int kk = 0; kk < 6; ++kk) {
                if (2 * kk < ntv) {
                    bf16x8 pf[2];
#pragma unroll
                    for (int mt = 0; mt < 2; ++mt) {
                        const f32x4 a = sacc[2 * kk][mt], b = sacc[2 * kk + 1][mt];
                        u32x4 w; w.x = pk_bf16(a.x, a.y); w.y = pk_bf16(a.z, a.w); w.z = pk_bf16(b.x, b.y); w.w = pk_bf16(b.z, b.w);
                        pf[mt] = *(bf16x8*)&w;
                    }
#pragma unroll
                    for (int dt = 0; dt < 4; ++dt) {
                        const bf16_t* vr = Vt + (dt * 16 + fr) * VT_STRIDE + kk * 32 + fq * 4;
                        const u32x2 v0 = *(const u32x2*)vr, v1 = *(const u32x2*)(vr + 16);
                        u32x4 w; w.x = v0.x; w.y = v0.y; w.z = v1.x; w.w = v1.y;
                        const bf16x8 vf = *(bf16x8*)&w;
                        oacc[dt][0] = __builtin_amdgcn_mfma_f32_16x16x32_bf16(vf, pf[0], oacc[dt][0], 0, 0, 0);
                        oacc[dt][1] = __builtin_amdgcn_mfma_f32_16x16x32_bf16(vf, pf[1], oacc[dt][1], 0, 0, 0);
                    }
                }
            }
#pragma unroll
            for (int mt = 0; mt < 2; ++mt)
#pragma unroll
                for (int dt = 0; dt < 4; ++dt) {
                    f32x4 o = oacc[dt][mt] * inv[mt];
                    st_bf16x4(p.AO + (size_t)(qrow0 + th * 32 + mt * 16 + fr) * DM + h * 64 + dt * 16 + fq * 4, o);
                }
        }
    }
}

__device__ __forceinline__ void ssd_item(int it, int slab, int& lr0, int& nvalid, int& slot, int& g) {
    const int nprompt = SLAB_SEQ * NCH * NG;
    if (it < nprompt) { g = it & 3; const int c = (it >> 2) & (NCH - 1), sq = it >> 9; lr0 = sq * SEQ + c * 64; nvalid = 64; slot = sq * NCH + c; }
    else { const int j = it - nprompt; g = j & 3; const int sb = j >> 2; lr0 = SLAB_ROWS + sb * SL; nvalid = 32; slot = SLAB_SEQ * NCH + sb; }
}
constexpr int XT_STRIDE = 72, BT_STRIDE = 72, BC_STRIDE = 136;

__device__ __forceinline__ void ssdA_phase(const Params& p, int slab) {
    const int bidp = bid_priv(), nblkp = nblk_priv();
    const int tidp = tid_priv();
    bf16_t* Xt = (bf16_t*)smem;
    bf16_t* Bt = (bf16_t*)(smem + 512 * XT_STRIDE * 2);
    float* wl = (float*)(smem + 512 * XT_STRIDE * 2 + 128 * BT_STRIDE * 2);
    const int tid = tidp, wid = tid >> 6, lane = tid & 63, fr = lane & 15, fq = lane >> 4;
    const int nitem = SLAB_SEQ * NCH * NG + ((slab == 0 && !NOSAMPLE) ? SB * NG : 0);
    for (int it = bidp; it < nitem; it += nblkp) {
        int lr0, nvalid, slot, g; ssd_item(it, slab, lr0, nvalid, slot, g);
        const int hd = g * 8 + wid;
        __syncthreads();
        {
            const float dtv = lane < nvalid ? softplus_f(bf2f(p.PROJ[(size_t)(lr0 + lane) * NWIN + PDT + hd]) + p.dt_bias[hd]) : 0.f;
            const float Ah = -__expf(p.a_log[hd]);
            float a = dtv * Ah;
#pragma unroll
            for (int o = 1; o < 64; o <<= 1) { const float t = shidx(a, lane >= o ? lane - o : lane, lane); if (lane >= o) a += t; }
            const float tot = shidx(a, 63, lane);
            wl[wid * 64 + lane] = dtv * __expf(tot - a);
            if (lane == 0) p.CDEC[slot * 32 + hd] = __expf(tot);
        }
        __syncthreads();
#pragma unroll
        for (int r = 0; r < 2; ++r) {
            const int idx = tid + 512 * r, l = idx >> 4, seg = idx & 15;
            u32x4 v = (u32x4){0u, 0u, 0u, 0u};
            if (l < nvalid) v = *(const u32x4*)(p.XC + (size_t)(lr0 + l) * CD_ + DI + g * 128 + seg * 8);
            bf16_t* d = Bt + (seg * 8) * BT_STRIDE + l;
            d[0 * BT_STRIDE] = (bf16_t)(v.x & 0xffff); d[1 * BT_STRIDE] = (bf16_t)(v.x >> 16); d[2 * BT_STRIDE] = (bf16_t)(v.y & 0xffff); d[3 * BT_STRIDE] = (bf16_t)(v.y >> 16);
            d[4 * BT_STRIDE] = (bf16_t)(v.z & 0xffff); d[5 * BT_STRIDE] = (bf16_t)(v.z >> 16); d[6 * BT_STRIDE] = (bf16_t)(v.w & 0xffff); d[7 * BT_STRIDE] = (bf16_t)(v.w >> 16);
        }
#pragma unroll
        for (int r = 0; r < 8; ++r) {
            const int idx = tid + 512 * r, l = idx >> 6, seg = idx & 63;
            u32x4 v = (u32x4){0u, 0u, 0u, 0u};
            if (l < nvalid) v = *(const u32x4*)(p.XC + (size_t)(lr0 + l) * CD_ + g * 512 + seg * 8);
            const float sc = wl[(seg >> 3) * 64 + l];
            const unsigned w0 = pk_bf16(bf_lo(v.x) * sc, bf_hi(v.x) * sc), w1 = pk_bf16(bf_lo(v.y) * sc, bf_hi(v.y) * sc), w2 = pk_bf16(bf_lo(v.z) * sc, bf_hi(v.z) * sc), w3 = pk_bf16(bf_lo(v.w) * sc, bf_hi(v.w) * sc);
            bf16_t* d = Xt + (seg * 8) * XT_STRIDE + l;
            d[0 * XT_STRIDE] = (bf16_t)(w0 & 0xffff); d[1 * XT_STRIDE] = (bf16_t)(w0 >> 16); d[2 * XT_STRIDE] = (bf16_t)(w1 & 0xffff); d[3 * XT_STRIDE] = (bf16_t)(w1 >> 16);
            d[4 * XT_STRIDE] = (bf16_t)(w2 & 0xffff); d[5 * XT_STRIDE] = (bf16_t)(w2 >> 16); d[6 * XT_STRIDE] = (bf16_t)(w3 & 0xffff); d[7 * XT_STRIDE] = (bf16_t)(w3 >> 16);
        }
        __syncthreads();
        bf16x8 xf[4][2];
#pragma unroll
        for (int pt = 0; pt < 4; ++pt)
#pragma unroll
            for (int ks = 0; ks < 2; ++ks) xf[pt][ks] = *(const bf16x8*)(Xt + (wid * 64 + pt * 16 + fr) * XT_STRIDE + ks * 32 + fq * 8);
        bf16_t* Sout = p.SH + ((size_t)slot * 32 + hd) * 8192;
#pragma unroll
        for (int half = 0; half < 2; ++half) {
            f32x4 acc[4][4];
#pragma unroll
            for (int nt = 0; nt < 4; ++nt) {
                bf16x8 bfm[2];
#pragma unroll
                for (int ks = 0; ks < 2; ++ks) bfm[ks] = *(const bf16x8*)(Bt + (half * 64 + nt * 16 + fr) * BT_STRIDE + ks * 32 + fq * 8);
#pragma unroll
                for (int pt = 0; pt < 4; ++pt) {
                    f32x4 a = (f32x4){0.f, 0.f, 0.f, 0.f};
                    a = __builtin_amdgcn_mfma_f32_16x16x32_bf16(bfm[0], xf[pt][0], a, 0, 0, 0);
                    a = __builtin_amdgcn_mfma_f32_16x16x32_bf16(bfm[1], xf[pt][1], a, 0, 0, 0);
                    acc[nt][pt] = a;
                }
            }
#pragma unroll
            for (int nt = 0; nt < 4; ++nt)
#pragma unroll
                for (int pt = 0; pt < 4; ++pt)
                    st_bf16x4(Sout + (pt * 16 + fr) * 128 + half * 64 + nt * 16 + fq * 4, acc[nt][pt]);
        }
    }
}

__device__ __forceinline__ void scan_phase(const Params& p, int slab) {
    const int bidp = bid_priv(), nblkp = nblk_priv();
    const int tidp = tid_priv();
    const int gt = bidp * 512 + tidp, ng = nblkp * 512;
    for (int e = gt; e < SLAB_SEQ * 32 * 2048; e += ng) {
        const int n4 = e & 31, pp = (e >> 5) & 63, hd = (e >> 11) & 31, sq = e >> 16;
        const size_t off = (size_t)hd * 8192 + pp * 128 + n4 * 4;
        float h0 = 0.f, h1 = 0.f, h2 = 0.f, h3 = 0.f;
        for (int c0 = 0; c0 < NCH; c0 += 8) {
            u32x2 s[8]; float dc[8];
#pragma unroll
            for (int j = 0; j < 8; ++j) { const int slot = sq * NCH + c0 + j; s[j] = *(const u32x2*)(p.SH + (size_t)slot * 32 * 8192 + off); dc[j] = p.CDEC[slot * 32 + hd]; }
#pragma unroll
            for (int j = 0; j < 8; ++j) {
                const int slot = sq * NCH + c0 + j;
                u32x2 w; w.x = pk_bf16(h0, h1); w.y = pk_bf16(h2, h3);
                *(u32x2*)(p.SH + (size_t)slot * 32 * 8192 + off) = w;
                h0 = h0 * dc[j] + bf_lo(s[j].x); h1 = h1 * dc[j] + bf_hi(s[j].x); h2 = h2 * dc[j] + bf_lo(s[j].y); h3 = h3 * dc[j] + bf_hi(s[j].y);
            }
        }
        const int b = slab * SLAB_SEQ + sq;
        *(f32x4*)(p.out + O_SSMP + (size_t)b * 32 * 8192 + off) = (f32x4){san(h0), san(h1), san(h2), san(h3)};
    }
    if (slab == 0 && !NOSAMPLE) {
        for (int e = gt; e < SB * 32 * 2048; e += ng) {
            const int sb = e >> 16; const size_t off = (size_t)(e & 65535) * 4; const int hd = (e >> 11) & 31;
            const int slot = SLAB_SEQ * NCH + sb;
            const u32x2 s = *(const u32x2*)(p.SH + (size_t)slot * 32 * 8192 + off);
            const float dc = p.CDEC[slot * 32 + hd];
            const f32x4 h = *(const f32x4*)(p.state_ssm + (size_t)sb * 32 * 8192 + off);
            st_bf16x4(p.SH + (size_t)slot * 32 * 8192 + off, h);
            if (!NO_SAMPLE_OUT) *(f32x4*)(p.out + O_SSMS + (size_t)sb * 32 * 8192 + off) = (f32x4){san(h.x * dc + bf_lo(s.x)), san(h.y * dc + bf_hi(s.x)), san(h.z * dc + bf_lo(s.y)), san(h.w * dc + bf_hi(s.y))};
        }
    }
}

__device__ __forceinline__ void ssdC_phase(const Params& p, int slab) {
    const int bidp = bid_priv(), nblkp = nblk_priv();
    const int tidp = tid_priv();
    bf16_t* Xt = (bf16_t*)smem;
    bf16_t* Bl = (bf16_t*)(smem + 512 * XT_STRIDE * 2);
    bf16_t* Cl = Bl + 64 * BC_STRIDE;
    float* acsl = (float*)(Cl + 64 * BC_STRIDE);
    float* dtl = acsl + 512;
    const int tid = tidp, wid = tid >> 6, lane = tid & 63, fr = lane & 15, fq = lane >> 4;
    const int nitem = SLAB_SEQ * NCH * NG + ((slab == 0 && !NOSAMPLE) ? SB * NG : 0);
    for (int it = bidp; it < nitem; it += nblkp) {
        int lr0, nvalid, slot, g; ssd_item(it, slab, lr0, nvalid, slot, g);
        const int hd = g * 8 + wid;
        __syncthreads();
        {
            const float dtv = lane < nvalid ? softplus_f(bf2f(p.PROJ[(size_t)(lr0 + lane) * NWIN + PDT + hd]) + p.dt_bias[hd]) : 0.f;
            const float Ah = -__expf(p.a_log[hd]);
            float a = dtv * Ah;
#pragma unroll
            for (int o = 1; o < 64; o <<= 1) { const float t = shidx(a, lane >= o ? lane - o : lane, lane); if (lane >= o) a += t; }
            acsl[wid * 64 + lane] = a; dtl[wid * 64 + lane] = dtv;
        }
#pragma unroll
        for (int which = 0; which < 2; ++which)
#pragma unroll
            for (int r = 0; r < 2; ++r) {
                const int idx = tid + 512 * r, l = idx >> 4, seg = idx & 15;
                u32x4 v = (u32x4){0u, 0u, 0u, 0u};
                if (l < nvalid) v = *(const u32x4*)(p.XC + (size_t)(lr0 + l) * CD_ + DI + which * 512 + g * 128 + seg * 8);
                *(u32x4*)((which ? Cl : Bl) + l * BC_STRIDE + seg * 8) = v;
            }
#pragma unroll
        for (int r = 0; r < 8; ++r) {
            const int idx = tid + 512 * r, l = idx >> 6, seg = idx & 63;
            u32x4 v = (u32x4){0u, 0u, 0u, 0u};
            if (l < nvalid) v = *(const u32x4*)(p.XC + (size_t)(lr0 + l) * CD_ + g * 512 + seg * 8);
            bf16_t* d = Xt + (seg * 8) * XT_STRIDE + l;
            d[0 * XT_STRIDE] = (bf16_t)(v.x & 0xffff); d[1 * XT_STRIDE] = (bf16_t)(v.x >> 16); d[2 * XT_STRIDE] = (bf16_t)(v.y & 0xffff); d[3 * XT_STRIDE] = (bf16_t)(v.y >> 16);
            d[4 * XT_STRIDE] = (bf16_t)(v.z & 0xffff); d[5 * XT_STRIDE] = (bf16_t)(v.z >> 16); d[6 * XT_STRIDE] = (bf16_t)(v.w & 0xffff); d[7 * XT_STRIDE] = (bf16_t)(v.w >> 16);
        }
        __syncthreads();
        f32x4 cb[4][4];
#pragma unroll
        for (int st = 0; st < 4; ++st)
#pragma unroll
            for (int lt = 0; lt < 4; ++lt) cb[st][lt] = (f32x4){0.f, 0.f, 0.f, 0.f};
#pragma unroll
        for (int ks = 0; ks < 4; ++ks) {
            bf16x8 bfm[4], cfm[4];
#pragma unroll
            for (int t = 0; t < 4; ++t) { bfm[t] = *(const bf16x8*)(Bl + (t * 16 + fr) * BC_STRIDE + ks * 32 + fq * 8); cfm[t] = *(const bf16x8*)(Cl + (t * 16 + fr) * BC_STRIDE + ks * 32 + fq * 8); }
#pragma unroll
            for (int st = 0; st < 4; ++st)
#pragma unroll
                for (int lt = 0; lt < 4; ++lt)
                    if (st <= lt) cb[st][lt] = __builtin_amdgcn_mfma_f32_16x16x32_bf16(bfm[st], cfm[lt], cb[st][lt], 0, 0, 0);
        }
        f32x4 yacc[4][4];
#pragma unroll
        for (int pt = 0; pt < 4; ++pt)
#pragma unroll
            for (int lt = 0; lt < 4; ++lt) yacc[pt][lt] = (f32x4){0.f, 0.f, 0.f, 0.f};
        const bf16_t* Hs = p.SH + ((size_t)slot * 32 + hd) * 8192;
#pragma unroll
        for (int ks = 0; ks < 4; ++ks) {
            bf16x8 hfm[4], cfm[4];
#pragma unroll
            for (int t = 0; t < 4; ++t) { hfm[t] = *(const bf16x8*)(Hs + (t * 16 + fr) * 128 + ks * 32 + fq * 8); cfm[t] = *(const bf16x8*)(Cl + (t * 16 + fr) * BC_STRIDE + ks * 32 + fq * 8); }
#pragma unroll
            for (int pt = 0; pt < 4; ++pt)
#pragma unroll
                for (int lt = 0; lt < 4; ++lt) yacc[pt][lt] = __builtin_amdgcn_mfma_f32_16x16x32_bf16(hfm[pt], cfm[lt], yacc[pt][lt], 0, 0, 0);
        }
        const float* ac = acsl + wid * 64; const float* dl = dtl + wid * 64;
        const float dskip = p.d_skip[hd];
        float acl[4];
#pragma unroll
        for (int lt = 0; lt < 4; ++lt) { acl[lt] = ac[lt * 16 + fr]; const float e = __expf(acl[lt]);
#pragma unroll
            for (int pt = 0; pt < 4; ++pt) yacc[pt][lt] = yacc[pt][lt] * e; }
#pragma unroll
        for (int st = 0; st < 4; ++st) {
            const f32x4 as = *(const f32x4*)(ac + st * 16 + fq * 4), ds = *(const f32x4*)(dl + st * 16 + fq * 4);
#pragma unroll
            for (int lt = 0; lt < 4; ++lt) {
                if (st <= lt) {
                    const int l = lt * 16 + fr, s0 = st * 16 + fq * 4;
                    f32x4 c = cb[st][lt], o;
                    o.x = (s0 + 0 <= l) ? c.x * __expf(acl[lt] - as.x) * ds.x : 0.f;
                    o.y = (s0 + 1 <= l) ? c.y * __expf(acl[lt] - as.y) * ds.y : 0.f;
                    o.z = (s0 + 2 <= l) ? c.z * __expf(acl[lt] - as.z) * ds.z : 0.f;
                    o.w = (s0 + 3 <= l) ? c.w * __expf(acl[lt] - as.w) * ds.w : 0.f;
                    if (s0 + 0 == l) o.x += dskip;
                    if (s0 + 1 == l) o.y += dskip;
                    if (s0 + 2 == l) o.z += dskip;
                    if (s0 + 3 == l) o.w += dskip;
                    cb[st][lt] = o;
                }
            }
        }
#pragma unroll
        for (int kk = 0; kk < 2; ++kk) {
            bf16x8 xf[4];
#pragma unroll
            for (int pt = 0; pt < 4; ++pt) {
                const bf16_t* xr = Xt + (wid * 64 + pt * 16 + fr) * XT_STRIDE + kk * 32 + fq * 4;
                const u32x2 v0 = *(const u32x2*)xr, v1 = *(const u32x2*)(xr + 16);
                u32x4 w; w.x = v0.x; w.y = v0.y; w.z = v1.x; w.w = v1.y; xf[pt] = *(bf16x8*)&w;
            }
#pragma unroll
            for (int lt = 0; lt < 4; ++lt) {
                if (2 * kk <= lt) {
                    const f32x4 a = cb[2 * kk][lt];
                    f32x4 b = (f32x4){0.f, 0.f, 0.f, 0.f};
                    if (2 * kk + 1 <= lt) b = cb[2 * kk + 1][lt];
                    u32x4 w; w.x = pk_bf16(a.x, a.y); w.y = pk_bf16(a.z, a.w); w.z = pk_bf16(b.x, b.y); w.w = pk_bf16(b.z, b.w);
                    const bf16x8 mf = *(bf16x8*)&w;
#pragma unroll
                    for (int pt = 0; pt < 4; ++pt) yacc[pt][lt] = __builtin_amdgcn_mfma_f32_16x16x32_bf16(xf[pt], mf, yacc[pt][lt], 0, 0, 0);
                }
            }
        }
#pragma unroll
        for (int lt = 0; lt < 4; ++lt) {
            const int l = lt * 16 + fr;
            const size_t row = (size_t)(lr0 + l);
            float ss = 0.f;
            const bool ok = l < nvalid;
#pragma unroll
            for (int pt = 0; pt < 4; ++pt) {
                const int col = hd * 64 + pt * 16 + fq * 4;
                u32x2 zw = (u32x2){0u, 0u};
                if (ok) zw = *(const u32x2*)(p.PROJ + row * NWIN + PZ + col);
                f32x4 y = yacc[pt][lt];
                y.x *= silu_f(bf_lo(zw.x)); y.y *= silu_f(bf_hi(zw.x)); y.z *= silu_f(bf_lo(zw.y)); y.w *= silu_f(bf_hi(zw.y));
                ss += (y.x * y.x + y.y * y.y) + (y.z * y.z + y.w * y.w);
                if (ok) st_bf16x4(p.Y + row * DI + col, y);
            }
            ss += shx(ss, 16, lane); ss += shx(ss, 32, lane);
            if (ok && fq == 0) p.SSQ[row * 32 + hd] = ss;
        }
    }
}

__device__ __forceinline__ void mix_phase(const Params& p, int slab) {
    const int tidp = tid_priv();
    const int bidp = bid_priv(), nblkp = nblk_priv();
    const int lane = tidp & 63, wv = tidp >> 6;
    const int nrow = (slab == 0 && !NOSAMPLE) ? LR : SLAB_ROWS;
    for (int lrow = bidp * 8 + wv; lrow < nrow; lrow += nblkp * 8) {
        const float sq = lane < 32 ? p.SSQ[(size_t)lrow * 32 + lane] : 0.f;
        const float rs = rsqrtf(wave_sum(sq, lane) * (1.f / DI) + EPS);
        const bf16_t* gr = p.PROJ + (size_t)lrow * NWIN + PG;
#pragma unroll
        for (int j = 0; j < 4; ++j) {
            const int c = (lane + 64 * j) * 4;
            const f32x4 a = *(const f32x4*)(p.MIXP + (size_t)lrow * DM + c), b = *(const f32x4*)(p.MIXA + (size_t)lrow * DM + c);
            const u32x2 gm = *(const u32x2*)(gr + c), ga = *(const u32x2*)(gr + DM + c);
            f32x4 o;
            o.x = sigmoid_f(bf_lo(gm.x)) * rs * a.x + sigmoid_f(bf_lo(ga.x)) * b.x;
            o.y = sigmoid_f(bf_hi(gm.x)) * rs * a.y + sigmoid_f(bf_hi(ga.x)) * b.y;
            o.z = sigmoid_f(bf_lo(gm.y)) * rs * a.z + sigmoid_f(bf_lo(ga.y)) * b.z;
            o.w = sigmoid_f(bf_hi(gm.y)) * rs * a.w + sigmoid_f(bf_hi(ga.y)) * b.w;
            st_bf16x4(p.MIX + (size_t)lrow * DM + c, o);
        }
    }
}

__device__ __forceinline__ void normres_all(const Params& p, int which) {
    const int bidp = bid_priv(), nblkp = nblk_priv();
    const int tidp = tid_priv();
    const int lane = tidp & 63, wv = tidp >> 6;
    for (int row = bidp * 8 + wv; row < TT; row += nblkp * 8) {
        float* y = p.out + (size_t)row * DM;
        if (which == 0) norm_res_row(p.D + (size_t)row * DM, xin_row(p, row), y, p.ffn1_post_g, 0.5f, p.mix_pre_g, p.U + (size_t)row * DM, lane);
        else norm_res_row(p.D + (size_t)row * DM, y, y, p.ffn2_post_g, 0.5f, nullptr, nullptr, lane);
        if ((NO_SAMPLE_OUT || DBG_YS) && which != 0 && row >= TP) { for (int j = 0; j < 4; ++j) ((u32x4*)y)[lane + 64 * j] = (u32x4){0xAAAAAAAAu, 0xAAAAAAAAu, 0xAAAAAAAAu, 0xAAAAAAAAu}; }
    }
}
__device__ __forceinline__ void normres_slab(const Params& p, int slab) {
    const int bidp = bid_priv(), nblkp = nblk_priv();
    const int tidp = tid_priv();
    const int lane = tidp & 63, wv = tidp >> 6;
    const int nrow = (slab == 0 && !NOSAMPLE) ? LR : SLAB_ROWS;
    for (int lrow = bidp * 8 + wv; lrow < nrow; lrow += nblkp * 8) {
        const int row = l2g_row(slab, lrow);
        float* y = p.out + (size_t)row * DM;
        norm_res_row(p.MIXP + (size_t)lrow * DM, y, y, p.mix_post_g, 1.0f, p.ffn2_pre_g, p.U + (size_t)row * DM, lane);
    }
}

constexpr int PH_PREP = 0, PH_GU1 = 1, PH_DN1 = 2, PH_NR1 = 3, PH_MIX0 = 4, MIX_PHASES = 10, PH_GU2 = PH_MIX0 + NSLAB * MIX_PHASES, PH_DN2 = PH_GU2 + 1, PH_NR3 = PH_GU2 + 2, PH_END = PH_GU2 + 3;

#define NEED_SYNC(ph) (!((ph) >= PH_MIX0 && (ph) < PH_GU2 && ((ph) - PH_MIX0) % MIX_PHASES == 5))
#ifndef PHASE_MASK
#define PHASE_MASK 0xffff
#endif
#define PM(k) ((PHASE_MASK >> (k)) & 1)
__device__ __forceinline__ void run_phase(const Params& p, int ph) {
    GemmDesc g{}; bool is_gemm = false; int nrep = 1;
    if (ph == PH_PREP) {
        if (PM(0)) {
        tr_jobs(p);
        prep_misc(p);
        norm0_phase(p);
        }
    } else if (ph == PH_GU1 || ph == PH_GU2) {
        g.A = p.U; g.lda = DM; g.Bt = ph == PH_GU1 ? p.WGU1 : p.WGU2; g.ldb = DM; g.K = DM; g.nM = TT / BM; g.nN = 2 * DFF / BM; g.nmain = g.nM; g.abase = 0; g.aextra = 0; g.epi = EPI_SWIGLU; g.Hout = p.H;
        is_gemm = true;
    } else if (DBG_EXPOSE == 4 && ph == PH_DN1) {
        const int tidp = tid_priv(); const int gt = bid_priv() * 512 + tidp, ng = nblk_priv() * 512;
        for (int i = gt; i < 16384 * 64; i += ng) {
            const int r = i >> 6, c4 = (i & 63) * 4;
            const u32x2 w = *(const u32x2*)(p.H + (size_t)r * DFF + c4);
            *(f32x4*)(p.out + O_SSMS + (size_t)i * 4) = (f32x4){bf_lo(w.x), bf_hi(w.x), bf_lo(w.y), bf_hi(w.y)};
        }
    } else if (ph == PH_DN1 || ph == PH_DN2) {
        g.A = p.H; g.lda = DFF; g.Bt = ph == PH_DN1 ? p.WD1 : p.WD2; g.ldb = DFF; g.K = DFF; g.nM = TT / BM; g.nN = DM / BM; g.nmain = g.nM; g.abase = 0; g.aextra = 0; g.epi = EPI_F32; g.Fout = p.D;
        is_gemm = true;
    } else if (ph == PH_NR1) {
        if (PM(9)) normres_all(p, 0);
    } else if (ph == PH_NR3) {
        if (PM(9)) normres_all(p, 2);
    } else {
        const int s = (ph - PH_MIX0) / MIX_PHASES, q = (ph - PH_MIX0) % MIX_PHASES;
        const int nlt = SLAB_ROWS / BM + ((s == 0 && !NOSAMPLE) ? TS / BM : 0);
        if (q == 0) {
            g.A = p.U; g.lda = DM; g.Bt = p.WIN; g.ldb = DM; g.K = DM; g.nM = SLAB_ROWS / BM; g.nN = NWIN / BM; g.nmain = g.nM; g.abase = s * (SLAB_ROWS / BM); g.aextra = 0; g.epi = EPI_BF16; g.Hout = p.PROJ; g.slab = s;
            nrep = (s == 0 && !NOSAMPLE) ? 2 : 1;
#if DBG_EXPOSE == 6
            nrep = 1; g.nM = 66; g.nmain = 66;
#endif
            is_gemm = true;
        } else if (q == 1) {
#if DBG_EXPOSE
            {
                const int tidp = tid_priv(); const int gt = bid_priv() * 512 + tidp, ng = nblk_priv() * 512;
                for (int i = gt; i < 16384 * 64; i += ng) {
                    const int r = i >> 6, c4 = (i & 63) * 4;
#if DBG_EXPOSE == 6
                    const u32x2 w = *(const u32x2*)(p.PROJ + (size_t)r * NWIN + PZ + c4);
#elif DBG_EXPOSE == 5
                    const f32x4 wf = *(const f32x4*)((const float*)p.PROJ + (size_t)r * NWIN + PV + c4);
                    *(f32x4*)(p.out + O_SSMS + (size_t)i * 4) = wf; continue;
                    const u32x2 w = (u32x2){0u, 0u};
#elif DBG_EXPOSE == 1
                    const u32x2 w = *(const u32x2*)(p.PROJ + (size_t)(16384 + (r & 511)) * NWIN + PZ + c4 + ((r >> 9) & 7) * 256);
#elif DBG_EXPOSE == 2
                    const u32x2 w = *(const u32x2*)(p.U + (size_t)(r + 49664) * DM + c4 + 512);
#else
                    const u32x2 w = *(const u32x2*)(p.WIN + (size_t)(PV + (r & 255)) * DM + c4 + (r >> 8) * 4 % 768);
#endif
                    *(f32x4*)(p.out + O_SSMS + (size_t)i * 4) = (f32x4){bf_lo(w.x), bf_hi(w.x), bf_lo(w.y), bf_hi(w.y)};
                }
            }
#else
            if (PM(3)) { rope_phase(p, s); conv_phase(p, s); }
#endif
        } else if (q == 2) {
            if (PM(4)) attn_phase(p, s);
            if (PM(5)) ssdA_phase(p, s);
        } else if (q == 3) {
            if (PM(6)) scan_phase(p, s);
        } else if (q == 4) {
            if (PM(7)) ssdC_phase(p, s);
        } else if (q == 5) {
            g.A = p.Y; g.lda = DI; g.Bt = p.WBRM; g.ldb = DI; g.K = DI; g.nM = nlt; g.nN = DM / BM; g.nmain = nlt; g.abase = 0; g.aextra = 0; g.epi = EPI_F32; g.Fout = p.MIXP; g.slab = s;
            is_gemm = true;
        } else if (q == 6) {
            g.A = p.AO; g.lda = DM; g.Bt = p.WBRA; g.ldb = DM; g.K = DM; g.nM = nlt; g.nN = DM / BM; g.nmain = nlt; g.abase = 0; g.aextra = 0; g.epi = EPI_F32; g.Fout = p.MIXA; g.slab = s;
            is_gemm = true;
        } else if (q == 7) {
            if (PM(9)) mix_phase(p, s);
        } else if (q == 8) {
            g.A = p.MIX; g.lda = DM; g.Bt = p.WO; g.ldb = DM; g.K = DM; g.nM = nlt; g.nN = DM / BM; g.nmain = nlt; g.abase = 0; g.aextra = 0; g.epi = EPI_F32; g.Fout = p.MIXP; g.slab = s;
            is_gemm = true;
        } else {
            if (PM(9)) normres_slab(p, s);
        }
    }
    if (PM(1)) if (is_gemm) {
        for (int rep = 0; rep < nrep; ++rep) {
            if (rep == 1) { g.abase = TP / BM; g.otile0 = SLAB_ROWS / BM; g.nM = TS / BM; g.nmain = g.nM; }
            gemm_phase(p, g);
        }
    }
}

template <int LO, int HI>
__global__ void __launch_bounds__(512) mk_fwd(Params p_arg) {
    cg::grid_group grid = cg::this_grid();
    for (int ph = LO; ph < HI; ++ph) {
        const __attribute__((address_space(4))) Params* pp = (const __attribute__((address_space(4))) Params*)__builtin_amdgcn_kernarg_segment_ptr();
        asm volatile("" : "+s"(pp));
        run_phase(*(const Params*)pp, ph);
        if (ph + 1 < HI && NEED_SYNC(ph)) {
            asm volatile("s_waitcnt vmcnt(0) lgkmcnt(0)" ::: "memory");
            __builtin_amdgcn_fence(__ATOMIC_RELEASE, "agent");
            grid.sync();
            __builtin_amdgcn_fence(__ATOMIC_ACQUIRE, "agent");
        }
    }
}

static inline size_t al256(size_t x) { return (x + 255) & ~(size_t)255; }

extern "C" void kernel_launch(void* const* d_in, const int* in_sizes, int n_in, void* d_out, int out_size, void* d_ws, size_t ws_size, hipStream_t stream) {
    static int grid_blocks = 0;
    if (!grid_blocks) {
        int dev = 0, cus = 0, per_cu = 0;
        (void)hipGetDevice(&dev);
        (void)hipDeviceGetAttribute(&cus, hipDeviceAttributeMultiprocessorCount, dev);
        (void)hipFuncSetAttribute((const void*)mk_fwd<0, PH_GU2>, hipFuncAttributeMaxDynamicSharedMemorySize, LDS_BYTES);
        (void)hipFuncSetAttribute((const void*)mk_fwd<PH_GU2, PH_END>, hipFuncAttributeMaxDynamicSharedMemorySize, LDS_BYTES);
        (void)hipOccupancyMaxActiveBlocksPerMultiprocessor(&per_cu, (const void*)mk_fwd<0, PH_GU2>, 512, LDS_BYTES);
        if (per_cu < 1) per_cu = 1;
        grid_blocks = cus * per_cu;
        (void)hipGetLastError();
    }
    Params p{};
    const float* const* in = (const float* const*)d_in;
    p.x_prompt = in[0]; p.x_sample = in[1]; p.state_conv = in[2]; p.state_ssm = in[3]; p.cache_k = in[4]; p.cache_v = in[5];
    p.ffn1_pre_g = in[6]; p.ffn1_w_gu = in[7]; p.ffn1_w_down = in[8]; p.ffn1_post_g = in[9]; p.mix_pre_g = in[10]; p.w_in = in[11];
    p.conv_w = in[12]; p.conv_b = in[13]; p.dt_bias = in[14]; p.a_log = in[15]; p.d_skip = in[16]; p.m_norm_g = in[17]; p.attn_sink = in[18];
    p.w_br_m = in[19]; p.w_br_a = in[20]; p.w_o = in[21]; p.mix_post_g = in[22]; p.ffn2_pre_g = in[23]; p.ffn2_w_gu = in[24]; p.ffn2_w_down = in[25]; p.ffn2_post_g = in[26];
    p.out = (float*)d_out;
    unsigned char* w = (unsigned char*)d_ws; size_t o = 0;
    auto take = [&](size_t bytes) { unsigned char* r = w + o; o = al256(o + bytes); return r; };
    p.WGU1 = (bf16_t*)take((size_t)2 * DFF * DM * 2); p.WD1 = (bf16_t*)take((size_t)DM * DFF * 2);
    p.WIN = (bf16_t*)take((size_t)NWIN * DM * 2); p.WBRM = (bf16_t*)take((size_t)DM * DI * 2); p.WBRA = (bf16_t*)take((size_t)DM * DM * 2); p.WO = (bf16_t*)take((size_t)DM * DM * 2);
    p.WGU2 = (bf16_t*)take((size_t)2 * DFF * DM * 2); p.WD2 = (bf16_t*)take((size_t)DM * DFF * 2);
    p.KS = (bf16_t*)take((size_t)SB * 160 * 256 * 2); p.VS = (bf16_t*)take((size_t)SB * 160 * 256 * 2);
    p.ROPE = (float2*)take((size_t)SEQ * 8 * 8); p.CDEC = (float*)take((size_t)NST * 32 * 4);
    p.U = (bf16_t*)take((size_t)TT * DM * 2);
    const size_t region = o;
    p.H = (bf16_t*)take((size_t)TT * DFF * 2); p.D = (float*)take((size_t)TT * DM * 4);
    const size_t ffn_end = o;
    o = region;
    p.PROJ = (bf16_t*)take((size_t)LR * NWIN * 2); p.XC = (bf16_t*)take((size_t)LR * CD_ * 2);
    p.SH = (bf16_t*)take((size_t)NST * 32 * 8192 * 2); p.Y = (bf16_t*)take((size_t)LR * DI * 2); p.SSQ = (float*)take((size_t)LR * 32 * 4);
    p.AO = (bf16_t*)take((size_t)LR * DM * 2); p.MIX = (bf16_t*)take((size_t)LR * DM * 2);
    p.QR = (bf16_t*)take((size_t)LR * DM * 2); p.KR = (bf16_t*)take((size_t)LR * 256 * 2);
    p.MIXP = (float*)p.SH;
    p.MIXA = (float*)p.XC;
    const size_t total = o > ffn_end ? o : ffn_end;
    if (total > ws_size) { fprintf(stderr, "kernel_launch: workspace too small: need %zu have %zu\n", total, ws_size); return; }
    void* args[] = {&p};
    hipError_t e = hipLaunchCooperativeKernel((const void*)mk_fwd<0, PH_GU2>, dim3(grid_blocks), dim3(512), args, LDS_BYTES, stream);
    if (e != hipSuccess) fprintf(stderr, "cooperative launch 1 failed: %s (grid %d)\n", hipGetErrorString(e), grid_blocks);
    e = hipLaunchCooperativeKernel((const void*)mk_fwd<PH_GU2, PH_END>, dim3(grid_blocks), dim3(512), args, LDS_BYTES, stream);
    if (e != hipSuccess) fprintf(stderr, "cooperative launch 2 failed: %s (grid %d)\n", hipGetErrorString(e), grid_blocks);
}
```
